# Optimizing an MI355X kernel written in HIP

```python
import jax, jax.numpy as jnp
from jax import lax
import numpy as np

D_MODEL = 1024
BATCH = 32
SEQ = 2048
DEPTH = 4
DEC_BATCH = 4
DEC_SEQ = 8192
PAST_LEN = 128

N_MIXERS = 2
N_GLA = (DEPTH + 1) // 2
N_SG = DEPTH // 2
GLA_HEADS = 4
GLA_DK = D_MODEL // 2
GLA_DV = D_MODEL
GLA_HK = GLA_DK // GLA_HEADS
GLA_HV = GLA_DV // GLA_HEADS
GLA_RANK = 16
GLA_TAU = 16.0
GLA_CHUNK = 64
SG_CHUNK = 128
SG_GROUPS = 4
SG_WIDTH = D_MODEL
SG_GD = SG_WIDTH // SG_GROUPS
FFN_HIDDEN = -(-8 * D_MODEL // 768) * 256
EPS = 1e-6

kernel_name = 'hybrid_gla_sgu_adaln_encoder'


def rms_norm(x, g):
    xf = x.astype(jnp.float32)
    y = xf * lax.rsqrt(jnp.mean(xf * xf, axis=-1, keepdims=True) + EPS)
    return (y * g.astype(jnp.float32)).astype(x.dtype)


def layer_norm(x, g, b):
    xf = x.astype(jnp.float32)
    mu = jnp.mean(xf, axis=-1, keepdims=True)
    xc = xf - mu
    y = xc * lax.rsqrt(jnp.mean(xc * xc, axis=-1, keepdims=True) + EPS)
    return (y * g.astype(jnp.float32) + b.astype(jnp.float32)).astype(x.dtype)


def gla_direction(q, k, v, log_a, include_diag):
    B, H, L, dk = q.shape
    dv = v.shape[-1]
    C = GLA_CHUNK
    n = L // C
    q = q.reshape(B, H, n, C, dk)
    k = k.reshape(B, H, n, C, dk)
    v = v.reshape(B, H, n, C, dv)
    b = jnp.cumsum(log_a.reshape(B, H, n, C, dk), axis=3)
    b_last = b[:, :, :, -1:, :]
    q_d = q * jnp.exp(b)
    k_d = k * jnp.exp(-b)
    k_end = k * jnp.exp(b_last - b)
    scores = jnp.einsum('bhncd,bhnsd->bhncs', q_d, k_d)
    mask = jnp.tril(jnp.ones((C, C), dtype=bool), 0 if include_diag else -1)
    scores = jnp.where(mask, scores, 0.0)
    o_intra = jnp.einsum('bhncs,bhnsv->bhncv', scores, v)
    decay = jnp.exp(b_last[:, :, :, 0, :])

    def step(S, inp):
        qd, ke, vc, dec = inp
        o = jnp.einsum('bhcd,bhdv->bhcv', qd, S)
        S = S * dec[..., None] + jnp.einsum('bhcd,bhcv->bhdv', ke, vc)
        return S, o

    xs = (jnp.moveaxis(q_d, 2, 0), jnp.moveaxis(k_end, 2, 0),
          jnp.moveaxis(v, 2, 0), jnp.moveaxis(decay, 2, 0))
    S0 = jnp.zeros((B, H, dk, dv), jnp.float32)
    _, o_inter = lax.scan(step, S0, xs)
    o = o_intra + jnp.moveaxis(o_inter, 0, 2)
    return o.reshape(B, H, L, dv)


def gla_mixer(h, w_in, w_gk1, w_gk2, b_gk, g_head, w_out):
    B, L, _ = h.shape
    proj = h @ w_in
    q, k, v, r = jnp.split(proj, [GLA_DK, 2 * GLA_DK, 2 * GLA_DK + GLA_DV], axis=-1)

    def heads(t, hd):
        return t.reshape(B, L, GLA_HEADS, hd).transpose(0, 2, 1, 3).astype(jnp.float32)

    q = heads(q, GLA_HK) * (GLA_HK ** -0.5)
    k = heads(k, GLA_HK)
    v = heads(v, GLA_HV)
    gate = jnp.einsum('bld,edr->eblr', h, w_gk1)
    gate = jnp.einsum('eblr,erk->eblk', gate, w_gk2) + b_gk[:, None, None, :]
    log_a = jax.nn.log_sigmoid(gate.astype(jnp.float32)) / GLA_TAU
    la_f = heads(log_a[0], GLA_HK)
    la_b = heads(log_a[1], GLA_HK)
    o_f = gla_direction(q, k, v, la_f, True)
    flip = lambda t: jnp.flip(t, axis=2)
    o_b = flip(gla_direction(flip(q), flip(k), flip(v), flip(la_b), False))
    o = rms_norm(o_f + o_b, g_head)
    o = o.transpose(0, 2, 1, 3).reshape(B, L, GLA_DV).astype(h.dtype)
    return (o * jax.nn.silu(r)) @ w_out


def sgu_mixer(h, w_in, b_in, ln_g, ln_b, w_s, b_s, w_out):
    B, L, _ = h.shape
    z = jax.nn.gelu(h @ w_in + b_in)
    u, v = jnp.split(z, 2, axis=-1)
    v = layer_norm(v, ln_g, ln_b)
    n = L // SG_CHUNK
    v = v.reshape(B, n, SG_CHUNK, SG_GROUPS, SG_GD)
    v = jnp.einsum('gts,bnsgd->bntgd', w_s, v) + b_s.T[None, None, :, :, None]
    v = v.reshape(B, L, SG_WIDTH)
    return (u * v) @ w_out


def trunk(x, c, norm_g, w_ada, b_ada,
          gla_w_in, gla_w_gk1, gla_w_gk2, gla_b_gk, gla_g_head, gla_w_out,
          sg_w_in, sg_b_in, sg_ln_g, sg_ln_b, sg_w_s, sg_b_s, sg_w_out,
          ffn_w_in, ffn_w_out):
    for i in range(DEPTH):
        mod = jax.nn.silu(c) @ w_ada[i] + b_ada[i]
        sh1, sc1, g1, sh2, sc2, g2 = jnp.split(mod[:, None, :], 6, axis=-1)
        h = rms_norm(x, norm_g[i, 0]) * (1 + sc1) + sh1
        j = i // N_MIXERS
        if i % N_MIXERS == 0:
            y = gla_mixer(h, gla_w_in[j], gla_w_gk1[j], gla_w_gk2[j], gla_b_gk[j],
                          gla_g_head[j], gla_w_out[j])
        else:
            y = sgu_mixer(h, sg_w_in[j], sg_b_in[j], sg_ln_g[j], sg_ln_b[j],
                          sg_w_s[j], sg_b_s[j], sg_w_out[j])
        x = x + g1 * rms_norm(y, norm_g[i, 1])
        h = rms_norm(x, norm_g[i, 2]) * (1 + sc2) + sh2
        a, bb = jnp.split(h @ ffn_w_in[i], 2, axis=-1)
        y = (jax.nn.silu(a) * bb) @ ffn_w_out[i]
        x = x + g2 * rms_norm(y, norm_g[i, 3])
    return x


def setup_inputs(seed: int = 0) -> dict:
    key = jax.random.key(seed)
    ks = jax.random.split(key, 24)
    D = D_MODEL
    nrm = lambda k, shape, s: jax.random.normal(k, shape, jnp.float32) * s
    return {
        'x_prompt': nrm(ks[0], (BATCH, SEQ, D), 1.0),
        'x_sample': nrm(ks[1], (DEC_BATCH, DEC_SEQ, D), 1.0),
        'c_prompt': nrm(ks[2], (BATCH, D), 1.0),
        'c_sample': nrm(ks[3], (DEC_BATCH, D), 1.0),
        'norm_g': 1.0 + nrm(ks[4], (DEPTH, 4, D), 0.05),
        'w_ada': nrm(ks[5], (DEPTH, D, 6 * D), 0.5 * D ** -0.5),
        'b_ada': nrm(ks[6], (DEPTH, 6 * D), 0.02),
        'gla_w_in': nrm(ks[7], (N_GLA, D, 2 * GLA_DK + 2 * GLA_DV), D ** -0.5),
        'gla_w_gk1': nrm(ks[8], (N_GLA, 2, D, GLA_RANK), D ** -0.5),
        'gla_w_gk2': nrm(ks[9], (N_GLA, 2, GLA_RANK, GLA_DK), GLA_RANK ** -0.5),
        'gla_b_gk': nrm(ks[10], (N_GLA, 2, GLA_DK), 0.1),
        'gla_g_head': 1.0 + nrm(ks[11], (N_GLA, GLA_HV), 0.05),
        'gla_w_out': nrm(ks[12], (N_GLA, GLA_DV, D), GLA_DV ** -0.5),
        'sg_w_in': nrm(ks[13], (N_SG, D, 2 * SG_WIDTH), D ** -0.5),
        'sg_b_in': nrm(ks[14], (N_SG, 2 * SG_WIDTH), 0.02),
        'sg_ln_g': 1.0 + nrm(ks[15], (N_SG, SG_WIDTH), 0.05),
        'sg_ln_b': nrm(ks[16], (N_SG, SG_WIDTH), 0.02),
        'sg_w_s': nrm(ks[17], (N_SG, SG_GROUPS, SG_CHUNK, SG_CHUNK), SG_CHUNK ** -0.5),
        'sg_b_s': 1.0 + nrm(ks[18], (N_SG, SG_GROUPS, SG_CHUNK), 0.1),
        'sg_w_out': nrm(ks[19], (N_SG, SG_WIDTH, D), SG_WIDTH ** -0.5),
        'ffn_w_in': nrm(ks[20], (DEPTH, D, 2 * FFN_HIDDEN), D ** -0.5),
        'ffn_w_out': nrm(ks[21], (DEPTH, FFN_HIDDEN, D), FFN_HIDDEN ** -0.5),
    }


def reference(x_prompt, x_sample, c_prompt, c_sample, norm_g, w_ada, b_ada,
              gla_w_in, gla_w_gk1, gla_w_gk2, gla_b_gk, gla_g_head, gla_w_out,
              sg_w_in, sg_b_in, sg_ln_g, sg_ln_b, sg_w_s, sg_b_s, sg_w_out,
              ffn_w_in, ffn_w_out):
    y_prompt = trunk(x_prompt, c_prompt, norm_g, w_ada, b_ada,
                     gla_w_in, gla_w_gk1, gla_w_gk2, gla_b_gk, gla_g_head, gla_w_out,
                     sg_w_in, sg_b_in, sg_ln_g, sg_ln_b, sg_w_s, sg_b_s, sg_w_out,
                     ffn_w_in, ffn_w_out)
    y_sample = trunk(x_sample, c_sample, norm_g, w_ada, b_ada,
                     gla_w_in, gla_w_gk1, gla_w_gk2, gla_b_gk, gla_g_head, gla_w_out,
                     sg_w_in, sg_b_in, sg_ln_g, sg_ln_b, sg_w_s, sg_b_s, sg_w_out,
                     ffn_w_in, ffn_w_out)
    return (y_prompt, y_sample)
```

```cpp
#include <hip/hip_runtime.h>
#include <hip/hip_cooperative_groups.h>
#include <cstdio>
#include <cstdint>
namespace cg = cooperative_groups;

namespace pg8 {
#define PG8_LAS __attribute__((address_space(3)))
typedef unsigned short bf16_t;
typedef short bf16x8 __attribute__((ext_vector_type(8)));
typedef float f32x4 __attribute__((ext_vector_type(4)));
typedef unsigned u32x4 __attribute__((ext_vector_type(4)));
constexpr int BM = 256, BK = 64, HALF = 128, HTB = HALF * BK * 2  , STAGE_BYTES = 8 * HTB, NXCD = 8, WGM = 8;

__host__ __device__ __forceinline__ int lds_byte(int r, int c) { const int st = (r >> 4) * 2 + (c >> 5), rr = r & 15, cc = c & 31, ob = rr * 64 + cc * 2; return st * 1024 + (ob ^ (((ob >> 9) & 1) << 5)); }
__host__ __device__ __forceinline__ void stage_rc(int b, int& R, int& C) { const int st = b / 1024, sb = b % 1024, swz = sb ^ (((sb >> 9) & 1) << 5); R = (st >> 1) * 16 + swz / 64; C = (st & 1) * 32 + (swz % 64) / 2; }
__host__ __device__ __forceinline__ int perm32(int rho) { const int n = rho >> 4, i = rho & 15; return 8 * (i >> 2) + 4 * n + (i & 3); }

struct Unit { int pm, pn; };
struct Gemm { const bf16_t* A; const bf16_t* Bt; int M, N, K; };

struct StaticOrder {
    int nM, nN, nwg, G, c;
    __host__ __device__ void init(int M, int N, int G_, int c_) { nM = M / BM; nN = N / BM; nwg = nM * nN; G = G_; c = c_; }
    __host__ __device__ bool next(int i, Unit& u) const {
        const long L = (long)i * G + c; if (L >= nwg) return false;
        int wgid = (int)L; { const int q = nwg / NXCD, r = nwg % NXCD, xcd = wgid % NXCD, off = wgid / NXCD; wgid = (xcd < r ? xcd * (q + 1) : r * (q + 1) + (xcd - r) * q) + off; }
        const int nig = WGM * nN, gid = wgid / nig, fm = gid * WGM, gsz = (nM - fm) < WGM ? (nM - fm) : WGM;
        u.pm = fm + ((wgid % nig) % gsz); u.pn = (wgid % nig) / gsz; return true;
    }
    __device__ __forceinline__ void a_ready(const Unit&) const {}
    __device__ __forceinline__ void done(const Unit&) const {}
};


__device__ __forceinline__ unsigned cvt_pk_bf16(float lo, float hi) { unsigned r; asm volatile("v_cvt_pk_bf16_f32 %0, %1, %2" : "=v"(r) : "v"(lo), "v"(hi)); return r; }
__device__ __forceinline__ float gelu_tanh(float x) { const float u = 0.7978845608028654f * (x + 0.044715f * x * x * x); return x * __builtin_amdgcn_rcpf(1.0f + __builtin_amdgcn_exp2f(-2.885390081777927f * u)); }
__device__ __forceinline__ float silu_f(float a) { return a * __builtin_amdgcn_rcpf(1.0f + __builtin_amdgcn_exp2f(-1.4426950408889634f * a)); }

struct EpiPlain {
    static constexpr bool PERM = true, AFTER_DRAIN = false;
    bf16_t* O; int ldc; int ncols; float* gate;
    __device__ __forceinline__ void operator()(const f32x4 (&acc)[2][2][4][2], const Unit& u, int wr, int wc, int fr, int fq) const {
        const int row0 = u.pm * BM + wr * 64 + fr; const int colt = u.pn * BM;
        if (colt < ncols) {
            const int col0 = colt + wc * 32 + 8 * fq;
#pragma unroll
            for (int ai = 0; ai < 2; ++ai)
#pragma unroll
                for (int m = 0; m < 4; ++m) { bf16_t* rowp = O + (size_t)(row0 + ai * HALF + m * 16) * ldc + col0;
#pragma unroll
                    for (int bj = 0; bj < 2; ++bj) { const f32x4 v0 = acc[ai][bj][m][0], v1 = acc[ai][bj][m][1];
                        u32x4 w; w.x = cvt_pk_bf16(v0[0], v0[1]); w.y = cvt_pk_bf16(v0[2], v0[3]); w.z = cvt_pk_bf16(v1[0], v1[1]); w.w = cvt_pk_bf16(v1[2], v1[3]);
                        *(u32x4*)(rowp + bj * HALF) = w; } }
        } else if (wc == 0) {
#pragma unroll
            for (int ai = 0; ai < 2; ++ai)
#pragma unroll
                for (int m = 0; m < 4; ++m) { float* gp = gate + (size_t)(row0 + ai * HALF + m * 16) * 32 + 8 * fq;
                    *(f32x4*)gp = acc[ai][0][m][0]; *(f32x4*)(gp + 4) = acc[ai][0][m][1]; }
        }
    }
};
struct EpiGelu {
    static constexpr bool PERM = true, AFTER_DRAIN = false;
    bf16_t* O; int ldc; const float* bias; float* stats; int stat_col0;
    __device__ __forceinline__ void operator()(const f32x4 (&acc)[2][2][4][2], const Unit& u, int wr, int wc, int fr, int fq) const {
        const int row0 = u.pm * BM + wr * 64 + fr; const int col0 = u.pn * BM + wc * 32 + 8 * fq;
        f32x4 bv[2][2];
#pragma unroll
        for (int bj = 0; bj < 2; ++bj)
#pragma unroll
            for (int n = 0; n < 2; ++n) bv[bj][n] = *(const f32x4*)(bias + col0 + bj * HALF + 4 * n);
#pragma unroll
        for (int ai = 0; ai < 2; ++ai)
#pragma unroll
            for (int m = 0; m < 4; ++m) { bf16_t* rowp = O + (size_t)(row0 + ai * HALF + m * 16) * ldc + col0;
                float s1 = 0.f, s2 = 0.f;
#pragma unroll
                for (int bj = 0; bj < 2; ++bj) { f32x4 v0 = acc[ai][bj][m][0] + bv[bj][0], v1 = acc[ai][bj][m][1] + bv[bj][1];
#pragma unroll
                    for (int i = 0; i < 4; ++i) { v0[i] = gelu_tanh(v0[i]); v1[i] = gelu_tanh(v1[i]); }
                    s1 += ((v0[0] + v0[1]) + (v0[2] + v0[3])) + ((v1[0] + v1[1]) + (v1[2] + v1[3]));
                    s2 += ((v0[0] * v0[0] + v0[1] * v0[1]) + (v0[2] * v0[2] + v0[3] * v0[3])) + ((v1[0] * v1[0] + v1[1] * v1[1]) + (v1[2] * v1[2] + v1[3] * v1[3]));
                    u32x4 w; w.x = cvt_pk_bf16(v0[0], v0[1]); w.y = cvt_pk_bf16(v0[2], v0[3]); w.z = cvt_pk_bf16(v1[0], v1[1]); w.w = cvt_pk_bf16(v1[2], v1[3]);
                    *(u32x4*)(rowp + bj * HALF) = w; }
                if (u.pn * BM >= stat_col0) {
                    s1 += __shfl_xor(s1, 16); s1 += __shfl_xor(s1, 32); s2 += __shfl_xor(s2, 16); s2 += __shfl_xor(s2, 32);
                    if (fq == 0) { float* sp = stats + (size_t)(row0 + ai * HALF + m * 16) * 32 + (((u.pn * BM - stat_col0) >> 8) * 4 + wc) * 2; sp[0] = s1; sp[1] = s2; } } }
    }
};
struct EpiSwiGLU {
    static constexpr bool PERM = true, AFTER_DRAIN = false;
    bf16_t* O; int ldc;
    __device__ __forceinline__ void operator()(const f32x4 (&acc)[2][2][4][2], const Unit& u, int wr, int wc, int fr, int fq) const {
        const int row0 = u.pm * BM + wr * 64 + fr; const int col0 = u.pn * HALF + wc * 32 + 8 * fq;
#pragma unroll
        for (int ai = 0; ai < 2; ++ai)
#pragma unroll
            for (int m = 0; m < 4; ++m) { bf16_t* rowp = O + (size_t)(row0 + ai * HALF + m * 16) * ldc + col0;
                f32x4 v0, v1;
#pragma unroll
                for (int i = 0; i < 4; ++i) { v0[i] = silu_f(acc[ai][0][m][0][i]) * acc[ai][1][m][0][i]; v1[i] = silu_f(acc[ai][0][m][1][i]) * acc[ai][1][m][1][i]; }
                u32x4 w; w.x = cvt_pk_bf16(v0[0], v0[1]); w.y = cvt_pk_bf16(v0[2], v0[3]); w.z = cvt_pk_bf16(v1[0], v1[1]); w.w = cvt_pk_bf16(v1[2], v1[3]);
                *(u32x4*)rowp = w; }
    }
};

template <class Epi, class Sched, bool ALIGN_EPI = false, bool SP2 = false>
__device__ __forceinline__ void gemm_phase(PG8_LAS unsigned char* lds, const Gemm g, const Sched& S, const Epi& E) {
    int tid_ = threadIdx.x; asm volatile("" : "+v"(tid_));
    const int tid = tid_, wid = __builtin_amdgcn_readfirstlane(tid >> 6), lane = tid & 63, wr = wid >> 2, wc = wid & 3, fr = lane & 15, fq = lane >> 4;
    const int K = g.K, nt = K / BK;
    unsigned voffA[2], voffB[2];
#pragma unroll
    for (int i = 0; i < 2; ++i) { int R, C; stage_rc(tid * 16 + i * 8192, R, C); const int Rb = Epi::PERM ? ((R & ~31) + perm32(R & 31)) : R;
        voffA[i] = (unsigned)(R * K + C) * 2u; voffB[i] = (unsigned)(Rb * K + C) * 2u; }
    const size_t kstep = (size_t)(BK * 2);
    const size_t hstep = (size_t)HALF * K * 2;
    const size_t tstep = 2 * hstep;
    const unsigned ldsw = (unsigned)wid * 1024u;
    const int aoff = lds_byte(wr * 64 + fr, fq * 8), boff = lds_byte(wc * 32 + fr, fq * 8);
#define PG8_SA(b, h) (((b) * 2 + (h)) * HTB)
#define PG8_SB(b, h) ((4 + (b) * 2 + (h)) * HTB)
#define PG8_STAGE(bufoff, gbase, voff) do { _Pragma("unroll") for (int _i = 0; _i < 2; ++_i) \
        __builtin_amdgcn_global_load_lds((const unsigned*)((const char*)(gbase) + (voff)[_i]), (PG8_LAS unsigned*)(lds + (bufoff) + ldsw + _i * 8192), 16, 0, 0); } while (0)
#define PG8_LDA(dst, b, h) do { _Pragma("unroll") for (int m = 0; m < 4; ++m) _Pragma("unroll") for (int k = 0; k < 2; ++k) dst[m][k] = *(const PG8_LAS bf16x8*)(lds + PG8_SA(b, h) + aoff + m * 2048 + k * 1024); } while (0)
#define PG8_LDB(dst, b, h) do { _Pragma("unroll") for (int n = 0; n < 2; ++n) _Pragma("unroll") for (int k = 0; k < 2; ++k) dst[n][k] = *(const PG8_LAS bf16x8*)(lds + PG8_SB(b, h) + boff + n * 2048 + k * 1024); } while (0)
#define PG8_MMA(ai, bj, At, Bt) do { __builtin_amdgcn_s_setprio(1); _Pragma("unroll") for (int m = 0; m < 4; ++m) _Pragma("unroll") for (int n = 0; n < 2; ++n) _Pragma("unroll") for (int k = 0; k < 2; ++k) \
        acc[ai][bj][m][n] = __builtin_amdgcn_mfma_f32_16x16x32_bf16(Bt[n][k], At[m][k], acc[ai][bj][m][n], 0, 0, 0); __builtin_amdgcn_s_setprio(0); } while (0)
#define PG8_WAIT_V(n) asm volatile("s_waitcnt vmcnt(" #n ")" ::: "memory")
#define PG8_WAIT_L(n) asm volatile("s_waitcnt lgkmcnt(" #n ")" ::: "memory")
#define PG8_BAR __builtin_amdgcn_s_barrier()
#define PG8_SCHED __builtin_amdgcn_sched_barrier(0)
    Unit cur, nxt; int ui = 0;
    if (!S.next(0, cur)) return;
    f32x4 acc[2][2][4][2];
#pragma unroll
    for (int a = 0; a < 2; ++a)
#pragma unroll
        for (int b = 0; b < 2; ++b)
#pragma unroll
            for (int m = 0; m < 4; ++m)
#pragma unroll
                for (int n = 0; n < 2; ++n) acc[a][b][m][n] = (f32x4){0.f, 0.f, 0.f, 0.f};
    bf16x8 At[4][2], B0[2][2], B1[2][2];
    const char* cA = (const char*)g.A + (size_t)cur.pm * tstep; const char* cB = (const char*)g.Bt + (size_t)cur.pn * tstep;
    S.a_ready(cur);
    if constexpr (SP2) {
        PG8_STAGE(PG8_SB(0, 0), cB, voffB); PG8_STAGE(PG8_SB(0, 1), cB + hstep, voffB); PG8_STAGE(PG8_SA(0, 0), cA, voffA); PG8_STAGE(PG8_SA(0, 1), cA + hstep, voffA);
        if (wr == 1) PG8_BAR;
        PG8_WAIT_V(2); PG8_BAR;
        PG8_STAGE(PG8_SB(1, 0), cB + kstep, voffB); PG8_STAGE(PG8_SA(1, 0), cA + kstep, voffA); PG8_STAGE(PG8_SB(1, 1), cB + hstep + kstep, voffB);
        PG8_WAIT_V(6); PG8_BAR;
    } else {
        PG8_STAGE(PG8_SB(0, 0), cB, voffB); PG8_STAGE(PG8_SA(0, 0), cA, voffA); PG8_STAGE(PG8_SB(0, 1), cB + hstep, voffB); PG8_STAGE(PG8_SA(0, 1), cA + hstep, voffA);
        if (wr == 1) PG8_BAR;
        PG8_WAIT_V(4); PG8_BAR;
        PG8_STAGE(PG8_SB(1, 0), cB + kstep, voffB); PG8_STAGE(PG8_SA(1, 0), cA + kstep, voffA); PG8_STAGE(PG8_SB(1, 1), cB + hstep + kstep, voffB);
        PG8_WAIT_V(6); PG8_BAR;
    }
    for (;;) {
        const bool has_next = S.next(ui + 1, nxt);
        const char* nA = has_next ? (const char*)g.A + (size_t)nxt.pm * tstep : cA; const char* nB = has_next ? (const char*)g.Bt + (size_t)nxt.pn * tstep : cB;
        for (int t = 0; t < nt; t += 2) {
            const bool last = (t == nt - 2);
            const char* a1 = cA + (size_t)(t + 1) * kstep;
            const char* a2 = last ? nA : cA + (size_t)(t + 2) * kstep; const char* b2 = last ? nB : cB + (size_t)(t + 2) * kstep;
            const char* a3 = a2 + kstep; const char* b3 = b2 + kstep;
            if (last && has_next) S.a_ready(nxt);
            if constexpr (SP2) {
            PG8_LDB(B0, 0, 0); PG8_LDB(B1, 0, 1); PG8_SCHED; PG8_LDA(At, 0, 0); PG8_STAGE(PG8_SA(1, 1), a1 + hstep, voffA);
            PG8_WAIT_V(8); PG8_WAIT_L(0); PG8_BAR; PG8_MMA(0, 0, At, B0); PG8_MMA(0, 1, At, B1); PG8_BAR; PG8_SCHED;
            PG8_LDA(At, 0, 1); PG8_STAGE(PG8_SB(0, 0), b2, voffB); PG8_STAGE(PG8_SB(0, 1), b2 + hstep, voffB); PG8_STAGE(PG8_SA(0, 0), a2, voffA);
            PG8_WAIT_V(8); PG8_WAIT_L(0); PG8_BAR; PG8_MMA(1, 0, At, B0); PG8_MMA(1, 1, At, B1); PG8_BAR; PG8_SCHED;
            PG8_LDB(B0, 1, 0); PG8_LDB(B1, 1, 1); PG8_SCHED; PG8_LDA(At, 1, 0); PG8_STAGE(PG8_SA(0, 1), a2 + hstep, voffA);
            PG8_WAIT_V(8); PG8_WAIT_L(0); PG8_BAR; PG8_MMA(0, 0, At, B0); PG8_MMA(0, 1, At, B1); PG8_BAR; PG8_SCHED;
            PG8_LDA(At, 1, 1); PG8_STAGE(PG8_SB(1, 0), b3, voffB); PG8_STAGE(PG8_SB(1, 1), b3 + hstep, voffB); PG8_STAGE(PG8_SA(1, 0), a3, voffA);
            PG8_WAIT_V(8); PG8_WAIT_L(0); PG8_BAR; PG8_MMA(1, 0, At, B0); PG8_MMA(1, 1, At, B1); PG8_BAR; PG8_SCHED;
            } else {
            PG8_LDB(B0, 0, 0); PG8_SCHED; PG8_LDA(At, 0, 0); PG8_STAGE(PG8_SA(1, 1), a1 + hstep, voffA);
            PG8_WAIT_L(8); PG8_BAR; PG8_WAIT_L(0); PG8_MMA(0, 0, At, B0); PG8_BAR; PG8_SCHED;
            PG8_LDB(B1, 0, 1); PG8_STAGE(PG8_SB(0, 0), b2, voffB);
            PG8_BAR; PG8_WAIT_L(0); PG8_MMA(0, 1, At, B1); PG8_BAR;
            PG8_LDA(At, 0, 1); PG8_STAGE(PG8_SA(0, 0), a2, voffA);
            PG8_BAR; PG8_WAIT_L(0); PG8_MMA(1, 0, At, B0); PG8_BAR; PG8_SCHED;
            PG8_STAGE(PG8_SB(0, 1), b2 + hstep, voffB);
            PG8_WAIT_V(6); PG8_BAR; PG8_MMA(1, 1, At, B1); PG8_BAR;
            PG8_LDB(B0, 1, 0); PG8_SCHED; PG8_LDA(At, 1, 0); PG8_STAGE(PG8_SA(0, 1), a2 + hstep, voffA);
            PG8_WAIT_L(8); PG8_BAR; PG8_WAIT_L(0); PG8_MMA(0, 0, At, B0); PG8_BAR; PG8_SCHED;
            PG8_LDB(B1, 1, 1); PG8_STAGE(PG8_SB(1, 0), b3, voffB);
            PG8_BAR; PG8_WAIT_L(0); PG8_MMA(0, 1, At, B1); PG8_BAR;
            PG8_LDA(At, 1, 1); PG8_STAGE(PG8_SA(1, 0), a3, voffA);
            PG8_BAR; PG8_WAIT_L(0); PG8_MMA(1, 0, At, B0); PG8_BAR; PG8_SCHED;
            PG8_STAGE(PG8_SB(1, 1), b3 + hstep, voffB);
            PG8_WAIT_V(6); PG8_BAR; PG8_MMA(1, 1, At, B1); PG8_BAR;
            }
        }
        if constexpr (ALIGN_EPI) { if (wr == 0) PG8_BAR; }
        if constexpr (!Epi::AFTER_DRAIN) { E(acc, cur, wr, wc, fr, fq); S.done(cur); }
        if (!has_next) break;
#pragma unroll
        for (int a = 0; a < 2; ++a)
#pragma unroll
            for (int b = 0; b < 2; ++b)
#pragma unroll
                for (int m = 0; m < 4; ++m)
#pragma unroll
                    for (int n = 0; n < 2; ++n) acc[a][b][m][n] = (f32x4){0.f, 0.f, 0.f, 0.f};
        cur = nxt; cA = nA; cB = nB; ++ui;
        if constexpr (ALIGN_EPI) { if (wr == 1) PG8_BAR; }
    }
    PG8_WAIT_V(0);
    if constexpr (!ALIGN_EPI) { if (wr == 0) PG8_BAR; }
    PG8_BAR;
    if constexpr (Epi::AFTER_DRAIN) { E.fused(acc, cur, wr, wc, fr, fq, lds, wid, lane); S.done(cur); }
#undef PG8_SA
#undef PG8_SB
#undef PG8_STAGE
#undef PG8_LDA
#undef PG8_LDB
#undef PG8_MMA
#undef PG8_WAIT_V
#undef PG8_WAIT_L
#undef PG8_BAR
#undef PG8_SCHED
}

}

typedef unsigned short bf16_t;
typedef float f32x4 __attribute__((ext_vector_type(4)));
typedef unsigned u32x4 __attribute__((ext_vector_type(4)));
typedef unsigned u32x2 __attribute__((ext_vector_type(2)));
typedef short bf16x8 __attribute__((ext_vector_type(8)));

constexpr int D = 1024, NTOK = 98304, NPT = 65536, NSEQ = 36, FFH = 2816;
constexpr float EPS = 1e-6f;
constexpr int LDS_BYTES = 135168;
constexpr size_t WS_BAR  = 0;
constexpr size_t WS_MOD  = 16384;
constexpr size_t WS_W1   = WS_MOD  + (size_t)NSEQ * 4 * 6144 * 4;
constexpr size_t WS_W2   = WS_W1   + (size_t)3328 * 1024 * 2;
constexpr size_t WS_W3   = WS_W2   + (size_t)1024 * 1024 * 2;
constexpr size_t WS_W4   = WS_W3   + (size_t)5632 * 1024 * 2;
constexpr size_t WS_WS   = WS_W4   + (size_t)1024 * 2816 * 2;
constexpr size_t WS_WSUM = WS_WS   + (size_t)4 * 128 * 128 * 2;
constexpr size_t WS_GATE = WS_WSUM + 4096;
constexpr size_t WS_A    = WS_GATE + (size_t)NTOK * 32 * 4;
constexpr size_t WS_O2   = WS_A    + (size_t)NTOK * 1024 * 2;
constexpr size_t WS_B    = WS_O2   + (size_t)NTOK * 1024 * 2;
constexpr size_t WS_END  = WS_B    + (size_t)NTOK * 3072 * 2;

struct Params { const float* in[22]; float* out; unsigned char* ws; };

__device__ __forceinline__ float wave_sum(float v) {
#pragma unroll
    for (int o = 1; o < 64; o <<= 1) v += __shfl_xor(v, o);
    return v;
}
__device__ __forceinline__ float bf2f(bf16_t b) { return __uint_as_float(((unsigned)b) << 16); }
typedef float f32x2_t __attribute__((ext_vector_type(2)));
typedef __bf16 bf16x2_t __attribute__((ext_vector_type(2)));
__device__ __forceinline__ unsigned pk2(float lo, float hi) { const f32x2_t v = {lo, hi}; return __builtin_bit_cast(unsigned, __builtin_convertvector(v, bf16x2_t)); }
__device__ __forceinline__ bf16_t f2bf(float f) { return (bf16_t)(pk2(f, 0.f) & 0xffffu); }
__device__ __forceinline__ f32x4 unpack4(u32x2 w) { f32x4 r; r[0] = __uint_as_float(w.x << 16); r[1] = __uint_as_float(w.x & 0xffff0000u); r[2] = __uint_as_float(w.y << 16); r[3] = __uint_as_float(w.y & 0xffff0000u); return r; }
__device__ __forceinline__ int seq_of(int tok) { return tok < NPT ? (tok >> 11) : 32 + ((tok - NPT) >> 13); }
#define LDS_WAIT() asm volatile("s_waitcnt lgkmcnt(0)" ::: "memory")
__device__ __forceinline__ int opaque_tid() { int t = threadIdx.x; asm volatile("" : "+v"(t)); return t; }

#define LAS __attribute__((address_space(3)))
#define XB_TMO      128
#define XB_XCNT(j)  (256  + 64 * (j))
#define XB_XSUB(j)  (1280 + 64 * (j))
#define XB_XGEN(j)  (2304 + 64 * (j))
#define XB_TOP      3328
#define XB_TOPGEN   3392
#define XCD_BAR_WORDS 3456
#define XB_SPIN_CAP (1u << 23)

__device__ __forceinline__ unsigned xb_ld(unsigned* p)              { return __hip_atomic_load(p, __ATOMIC_RELAXED, __HIP_MEMORY_SCOPE_AGENT); }
__device__ __forceinline__ unsigned xb_add(unsigned* p, unsigned v) { return __hip_atomic_fetch_add(p, v, __ATOMIC_RELAXED, __HIP_MEMORY_SCOPE_AGENT); }
__device__ __forceinline__ unsigned xb_xcc_id() { return (unsigned)__builtin_amdgcn_s_getreg((3 << 11) | 20) & 0xFu; }
#define XB_SPIN(cond, bar) do { unsigned _sp = 0; while (cond) { __builtin_amdgcn_s_sleep(1); \
    if ((++_sp & 255u) == 0u) { if (xb_ld(&(bar)[XB_TMO])) break; if (_sp > XB_SPIN_CAP) { atomicAdd(&(bar)[XB_TMO], 1u); break; } } } } while (0)

struct XcdBarrier {
    unsigned* bar; unsigned x;
    volatile LAS unsigned* st;
};

__device__ __forceinline__ XcdBarrier xcd_barrier_post(unsigned* bar, volatile LAS unsigned* st) {
    XcdBarrier b; b.bar = bar; b.x = xb_xcc_id(); b.st = st;
    if (threadIdx.x == 0) (void)xb_add(&bar[XB_XCNT(b.x)], 1u);
    return b;
}
__device__ __forceinline__ void xcd_barrier_complete(unsigned* bar, unsigned x, unsigned& nloc, unsigned& nx) {
    const unsigned G = gridDim.x * gridDim.y * gridDim.z;
    unsigned sum, cnt, mine, sp = 0u;
    for (;;) {
        sum = 0u; cnt = 0u; mine = 0u;
#pragma unroll
        for (unsigned j = 0; j < 16; ++j) { const unsigned c = xb_ld(&bar[XB_XCNT(j)]); sum += c; cnt += (c > 0u) ? 1u : 0u; mine = (j == x) ? c : mine; }
        if (sum == G) break;
        __builtin_amdgcn_s_sleep(1);
        if ((++sp & 255u) == 0u) { if (xb_ld(&bar[XB_TMO])) break; if (sp > XB_SPIN_CAP) { atomicAdd(&bar[XB_TMO], 1u); break; } }
    }
    nloc = mine > 0u ? mine : 1u; nx = cnt > 0u ? cnt : 1u;
}

__device__ __forceinline__ void xcd_barrier(const XcdBarrier& b) {
    asm volatile("s_waitcnt vmcnt(0)" ::: "memory");
    __syncthreads();
    if (threadIdx.x == 0) {
        unsigned* bar = b.bar;
        __builtin_amdgcn_s_waitcnt(0);
        unsigned nloc = b.st[0], nx = b.st[1];
        if (nloc == 0u) { xcd_barrier_complete(bar, b.x, nloc, nx); b.st[0] = nloc; b.st[1] = nx; }
        const unsigned old = xb_add(&bar[XB_XSUB(b.x)], 1u);
        const unsigned gen = old / nloc;
        if (old + 1u == (gen + 1u) * nloc) {
            __builtin_amdgcn_fence(__ATOMIC_RELEASE, "agent");
            asm volatile("s_waitcnt vmcnt(0)" ::: "memory");
            const unsigned og = xb_add(&bar[XB_TOP], 1u);
            const unsigned tg = og / nx;
            if (og + 1u == (tg + 1u) * nx) xb_add(&bar[XB_TOPGEN], 1u);
            else XB_SPIN(xb_ld(&bar[XB_TOPGEN]) == tg, bar);
            __builtin_amdgcn_fence(__ATOMIC_ACQUIRE, "agent");
            xb_add(&bar[XB_XGEN(b.x)], 1u);
            asm volatile("s_waitcnt vmcnt(0)" ::: "memory");
        } else {
            XB_SPIN(xb_ld(&bar[XB_XGEN(b.x)]) == gen, bar);
            __builtin_amdgcn_fence(__ATOMIC_ACQUIRE, "agent");
            asm volatile("s_waitcnt vmcnt(0)" ::: "memory");
        }
    }
    __syncthreads();
}


__device__ __forceinline__ void phase_mod(const Params& p, unsigned char* lds) {
    float* scs = (float*)lds;
    float* red = (float*)(lds + 36864);
    const float* c_prompt = p.in[2]; const float* c_sample = p.in[3]; const float* w_ada = p.in[5]; const float* b_ada = p.in[6];
    float* mod = (float*)(p.ws + WS_MOD);
    const int tid = opaque_tid(), col = tid % 96, kq = tid / 96;
    for (int item = blockIdx.x; item < 256; item += gridDim.x) {
        const int l = item >> 6, col0 = (item & 63) * 96;
        float acc[36];
#pragma unroll
        for (int s = 0; s < 36; ++s) acc[s] = 0.f;
        for (int k0 = 0; k0 < 1024; k0 += 256) {
            __syncthreads();
            for (int e = tid; e < 36 * 256; e += 512) { const int s = e >> 8, kk = e & 255;
                const float c = s < 32 ? c_prompt[s * 1024 + k0 + kk] : c_sample[(s - 32) * 1024 + k0 + kk];
                scs[kk * 36 + s] = c / (1.0f + __expf(-c)); }
            __syncthreads();
            if (tid < 384) {
                const float* wp = w_ada + ((size_t)l * 1024 + k0 + kq * 64) * 6144 + col0 + col;
                for (int kb = 0; kb < 64; kb += 16) {
                    float w[16];
#pragma unroll
                    for (int u = 0; u < 16; ++u) w[u] = __builtin_nontemporal_load(wp + (size_t)(kb + u) * 6144);
#pragma unroll
                    for (int u = 0; u < 16; ++u) { const f32x4* sp = (const f32x4*)(scs + (kq * 64 + kb + u) * 36);
#pragma unroll
                        for (int s4 = 0; s4 < 9; ++s4) { const f32x4 sv = sp[s4];
                            acc[4 * s4 + 0] += sv[0] * w[u]; acc[4 * s4 + 1] += sv[1] * w[u]; acc[4 * s4 + 2] += sv[2] * w[u]; acc[4 * s4 + 3] += sv[3] * w[u]; } }
                }
            }
        }
        __syncthreads();
        if (tid < 384) {
#pragma unroll
            for (int s = 0; s < 36; ++s) red[(kq * 96 + col) * 36 + s] = acc[s];
        }
        __syncthreads();
        for (int e = tid; e < 96 * 36; e += 512) { const int cc = e % 96, s = e / 96;
            const float v = red[(0 * 96 + cc) * 36 + s] + red[(1 * 96 + cc) * 36 + s] + red[(2 * 96 + cc) * 36 + s] + red[(3 * 96 + cc) * 36 + s] + b_ada[l * 6144 + col0 + cc];
            mod[((size_t)s * 4 + l) * 6144 + col0 + cc] = v; }
    }
    __syncthreads();
}

struct RowId  { __device__ __forceinline__ int operator()(int n) const { return n; } };
struct RowFfn { __device__ __forceinline__ int operator()(int n) const { const int b = n >= FFH ? 1 : 0; const int j = n - b * FFH; return (j >> 7) * 256 + b * 128 + (j & 127); } };
template <class RM>
__device__ __forceinline__ void transpose_item(const float* W, int K, int N, bf16_t* WT, RM rm, float* scr, int item, int lane) {
    const int nblk = N >> 5, kb = item / nblk, nb = item - kb * nblk, k0 = 64 * kb, n0 = 32 * nb;
#pragma unroll 8
    for (int i = 0; i < 32; ++i) { const int kk = 2 * i + (lane >> 5); scr[kk * 33 + (lane & 31)] = W[(size_t)(k0 + kk) * N + n0 + (lane & 31)]; }
    LDS_WAIT();
    const int c = lane & 7;
#pragma unroll
    for (int j = 0; j < 4; ++j) { const int n = (lane >> 3) + 8 * j; const float* s = scr + (8 * c) * 33 + n;
        u32x4 o; o.x = pk2(s[0 * 33], s[1 * 33]); o.y = pk2(s[2 * 33], s[3 * 33]); o.z = pk2(s[4 * 33], s[5 * 33]); o.w = pk2(s[6 * 33], s[7 * 33]);
        *(u32x4*)(WT + (size_t)rm(n0 + n) * K + k0 + 8 * c) = o; }
    LDS_WAIT();
}
__device__ __forceinline__ void phase_convert(const Params& p, int l, unsigned char* lds) {
    const int tid = opaque_tid(), lane = tid & 63, wave = __builtin_amdgcn_readfirstlane(tid >> 6), j = l >> 1; const int gw = blockIdx.x * 8 + wave, NGW = gridDim.x * 8; const bool gla = (l & 1) == 0;
    float* scr = (float*)(lds + wave * 8448);
    bf16_t* W1 = (bf16_t*)(p.ws + WS_W1); bf16_t* W2 = (bf16_t*)(p.ws + WS_W2); bf16_t* W3 = (bf16_t*)(p.ws + WS_W3); bf16_t* W4 = (bf16_t*)(p.ws + WS_W4);
    const int n1 = gla ? 3072 : 2048;
    const float *wi0 = p.in[7], *wi1 = p.in[13], *wo0 = p.in[12], *wo1 = p.in[19];
    asm volatile("" : "+s"(wi0), "+s"(wi1), "+s"(wo0), "+s"(wo1));
    const float* win = gla ? wi0 + (size_t)j * 1024 * 3072 : wi1 + (size_t)j * 1024 * 2048;
    const float* wout = (gla ? wo0 : wo1) + (size_t)j * 1024 * 1024;
    const float* fin = p.in[20] + (size_t)l * 1024 * 5632; const float* fout = p.in[21] + (size_t)l * FFH * 1024;
    const int I1 = 16 * (n1 / 32), I2 = 16 * 32, I3 = 16 * 176, I4 = 44 * 32, NI = I1 + I2 + I3 + I4;
    for (int it = gw; it < NI; it += NGW) {
        int r = it;
        if (r < I1) { transpose_item(win, 1024, n1, W1, RowId(), scr, r, lane); continue; } r -= I1;
        if (r < I2) { transpose_item(wout, 1024, 1024, W2, RowId(), scr, r, lane); continue; } r -= I2;
        if (r < I3) { transpose_item(fin, 1024, 5632, W3, RowFfn(), scr, r, lane); continue; } r -= I3;
        transpose_item(fout, FFH, 1024, W4, RowId(), scr, r, lane);
    }
    const int gt = gw * 64 + lane, NGT = NGW * 64;
    if (gla) {
        const float* gk1 = p.in[8] + (size_t)j * 2 * 1024 * 16;
        for (int e = gt; e < 32 * 1024; e += NGT) { const int row = e >> 10, k = e & 1023, ee = row >> 4, r = row & 15;
            W1[(size_t)(3072 + row) * 1024 + k] = f2bf(gk1[((size_t)ee * 1024 + k) * 16 + r]); }
    } else {
        const float* wsrc = p.in[17] + (size_t)j * 4 * 128 * 128; bf16_t* WS = (bf16_t*)(p.ws + WS_WS);
        for (int e = gt; e < 4 * 128 * 128; e += NGT) WS[e] = f2bf(wsrc[e]);
        float* wsum = (float*)(p.ws + WS_WSUM);
        for (int e = gt; e < 4 * 128; e += NGT) { float a = 0.f; for (int s2 = 0; s2 < 128; ++s2) a += bf2f(f2bf(wsrc[(size_t)e * 128 + s2])); wsum[e] = a; }
    }
}

struct V8 { f32x4 lo, hi; };
__device__ __forceinline__ V8 unpack8(u32x4 w) { V8 r; r.lo = unpack4((u32x2){w.x, w.y}); r.hi = unpack4((u32x2){w.z, w.w}); return r; }
__device__ __forceinline__ u32x4 pack8(f32x4 lo, f32x4 hi) { return (u32x4){pk2(lo[0], lo[1]), pk2(lo[2], lo[3]), pk2(hi[0], hi[1]), pk2(hi[2], hi[3])}; }
__device__ __forceinline__ float sumsq4(f32x4 v) { return (v[0] * v[0] + v[1] * v[1]) + (v[2] * v[2] + v[3] * v[3]); }
template <int x_mode_in>
__device__ __forceinline__ void phase_elem(const Params& p, bool has_y, int l_res, int jg, int ngi_res, int x_mode_out, bool write_h, int l_h, int jsh, int ngi_h) {
    const int tid = opaque_tid(), lane = tid & 63, gw = blockIdx.x * 8 + __builtin_amdgcn_readfirstlane(tid >> 6), NGW = gridDim.x * 8;
    const float* mod = (const float*)(p.ws + WS_MOD); const float* norm_g = p.in[4];
    const bf16_t* Y = (const bf16_t*)(p.ws + WS_O2); bf16_t* H = (bf16_t*)(p.ws + WS_A); bf16_t* XB = (bf16_t*)p.out;
    for (int b = gw; b < NTOK / 16; b += NGW) {
        const int pos = b >> 4, pmo = 48 * ((pos & 63) >> 3) + 8 * (pos >> 6) + (pos & 7);
        const int tok0 = pmo * 256 + (b & 15) * 16, s = seq_of(tok0);
        f32x4 ar[2][2], ah[2][2], sh[2][2];
#pragma unroll
        for (int j = 0; j < 2; ++j)
#pragma unroll
            for (int k = 0; k < 2; ++k) { ar[j][k] = (f32x4){0.f, 0.f, 0.f, 0.f}; ah[j][k] = ar[j][k]; sh[j][k] = ar[j][k]; }
        if (has_y) { const float* gp = mod + (((size_t)s * 4 + l_res) * 6 + jg) * 1024 + 8 * lane; const float* np = norm_g + (l_res * 4 + ngi_res) * 1024 + 8 * lane;
#pragma unroll
            for (int j = 0; j < 2; ++j)
#pragma unroll
                for (int k = 0; k < 2; ++k) ar[j][k] = *(const f32x4*)(gp + 512 * j + 4 * k) * *(const f32x4*)(np + 512 * j + 4 * k); }
        if (write_h) { const float* shp = mod + (((size_t)s * 4 + l_h) * 6 + jsh) * 1024 + 8 * lane; const float* scp = shp + 1024; const float* np = norm_g + (l_h * 4 + ngi_h) * 1024 + 8 * lane;
#pragma unroll
            for (int j = 0; j < 2; ++j)
#pragma unroll
                for (int k = 0; k < 2; ++k) { ah[j][k] = *(const f32x4*)(np + 512 * j + 4 * k) * (*(const f32x4*)(scp + 512 * j + 4 * k) + 1.0f); sh[j][k] = *(const f32x4*)(shp + 512 * j + 4 * k); } }
        f32x4 xr[2][2][2][2]; u32x4 xb[2][2][2], yb[2][2][2];
#define ELEM_LOAD(buf, tk) do { _Pragma("unroll") for (int q_ = 0; q_ < 2; ++q_) { const int tk_ = (tk) + q_; \
            if (x_mode_in == 0) { const float* xs_ = (tk_ < NPT ? p.in[0] + (size_t)tk_ * 1024 : p.in[1] + (size_t)(tk_ - NPT) * 1024) + 8 * lane; \
                _Pragma("unroll") for (int j = 0; j < 2; ++j) { xr[buf][q_][j][0] = *(const f32x4*)(xs_ + 512 * j); xr[buf][q_][j][1] = *(const f32x4*)(xs_ + 512 * j + 4); } } \
            else { _Pragma("unroll") for (int j = 0; j < 2; ++j) xb[buf][q_][j] = *(const u32x4*)(XB + (size_t)tk_ * 2048 + 512 * j + 8 * lane); } \
            if (has_y) { _Pragma("unroll") for (int j = 0; j < 2; ++j) yb[buf][q_][j] = *(const u32x4*)(Y + (size_t)tk_ * 1024 + 512 * j + 8 * lane); } } } while (0)
#define ELEM_BODY(buf, q_, tok_) do { const int tok = (tok_); \
            f32x4 x[2][2], y[2][2]; \
            _Pragma("unroll") for (int j = 0; j < 2; ++j) { \
                if (x_mode_in == 0) { x[j][0] = xr[buf][q_][j][0]; x[j][1] = xr[buf][q_][j][1]; } else { const V8 t_ = unpack8(xb[buf][q_][j]); x[j][0] = t_.lo; x[j][1] = t_.hi; } \
                if (has_y) { const V8 t_ = unpack8(yb[buf][q_][j]); y[j][0] = t_.lo; y[j][1] = t_.hi; } else { y[j][0] = (f32x4){0.f, 0.f, 0.f, 0.f}; y[j][1] = y[j][0]; } } \
            if (has_y) { const float ss = (sumsq4(y[0][0]) + sumsq4(y[0][1])) + (sumsq4(y[1][0]) + sumsq4(y[1][1])); \
                const float r = rsqrtf(wave_sum(ss) * (1.0f / 1024.0f) + EPS); \
                _Pragma("unroll") for (int j = 0; j < 2; ++j) _Pragma("unroll") for (int k = 0; k < 2; ++k) x[j][k] += ar[j][k] * (y[j][k] * r); } \
            if (x_mode_out == 2) { _Pragma("unroll") for (int j = 0; j < 2; ++j) _Pragma("unroll") for (int k = 0; k < 2; ++k) *(f32x4*)(p.out + (size_t)tok * 1024 + 512 * j + 8 * lane + 4 * k) = x[j][k]; } \
            else if (x_mode_out == 1) { _Pragma("unroll") for (int j = 0; j < 2; ++j) { const u32x4 w = pack8(x[j][0], x[j][1]); *(u32x4*)(XB + (size_t)tok * 2048 + 512 * j + 8 * lane) = w; \
                    const V8 t_ = unpack8(w); x[j][0] = t_.lo; x[j][1] = t_.hi; } } \
            if (write_h) { const float ss = (sumsq4(x[0][0]) + sumsq4(x[0][1])) + (sumsq4(x[1][0]) + sumsq4(x[1][1])); \
                const float r = rsqrtf(wave_sum(ss) * (1.0f / 1024.0f) + EPS); \
                _Pragma("unroll") for (int j = 0; j < 2; ++j) { const f32x4 h0 = (x[j][0] * r) * ah[j][0] + sh[j][0], h1 = (x[j][1] * r) * ah[j][1] + sh[j][1]; \
                    *(u32x4*)(H + (size_t)tok * 1024 + 512 * j + 8 * lane) = pack8(h0, h1); } } } while (0)
        ELEM_LOAD(0, tok0);
#pragma unroll 1
        for (int t = 0; t < 16; t += 4) {
            ELEM_LOAD(1, tok0 + t + 2);
            ELEM_BODY(0, 0, tok0 + t); ELEM_BODY(0, 1, tok0 + t + 1);
            if (t + 4 < 16) ELEM_LOAD(0, tok0 + t + 4);
            ELEM_BODY(1, 0, tok0 + t + 2); ELEM_BODY(1, 1, tok0 + t + 3);
        }
#undef ELEM_BODY
#undef ELEM_LOAD
    }
}

__device__ __forceinline__ void phase_gla_combine(const Params& p, int jl) {
    const int tid = opaque_tid(), lane = tid & 63, gw = blockIdx.x * 8 + __builtin_amdgcn_readfirstlane(tid >> 6), NGW = gridDim.x * 8;
    bf16_t* OF = (bf16_t*)(p.ws + WS_A); const bf16_t* OB = (const bf16_t*)(p.ws + WS_O2); const bf16_t* PR = (const bf16_t*)(p.ws + WS_B);
    const float* ghp = p.in[11] + jl * 256 + 8 * (lane & 31); const f32x4 gh0 = *(const f32x4*)ghp, gh1 = *(const f32x4*)(ghp + 4);
    for (int tok = gw; tok < NTOK; tok += NGW) {
        u32x4 a[2], bq[2], rq[2], c[2], d[2];
#pragma unroll
        for (int j = 0; j < 2; ++j) { const size_t off = (size_t)tok * 1024 + 512 * j + 8 * lane;
            a[j] = *(const u32x4*)(OF + off); bq[j] = *(const u32x4*)(OB + off); rq[j] = *(const u32x4*)(PR + (size_t)tok * 3072 + 2048 + 512 * j + 8 * lane);
            if (tok >= NPT) { const bf16_t* XS = (const bf16_t*)p.out + 1024 + 512 * j + 8 * lane;
                c[j] = *(const u32x4*)(XS + (size_t)tok * 2048); d[j] = *(const u32x4*)(XS + (size_t)(tok - NPT) * 2048); } }
#pragma unroll
        for (int j = 0; j < 2; ++j) { const size_t off = (size_t)tok * 1024 + 512 * j + 8 * lane;
            const V8 va = unpack8(a[j]), vb = unpack8(bq[j]), vr = unpack8(rq[j]); f32x4 o0 = va.lo + vb.lo, o1 = va.hi + vb.hi;
            if (tok >= NPT) { const V8 vc = unpack8(c[j]), vd = unpack8(d[j]); o0 += vc.lo + vd.lo; o1 += vc.hi + vd.hi; }
            float ss = sumsq4(o0) + sumsq4(o1);
#pragma unroll
            for (int m = 1; m < 32; m <<= 1) ss += __shfl_xor(ss, m);
            const float r = rsqrtf(ss * (1.0f / 256.0f) + EPS);
            f32x4 m0, m1;
#pragma unroll
            for (int i = 0; i < 4; ++i) { m0[i] = o0[i] * r * gh0[i] * pg8::silu_f(vr.lo[i]); m1[i] = o1[i] * r * gh1[i] * pg8::silu_f(vr.hi[i]); }
            *(u32x4*)(OF + off) = pack8(m0, m1); }
    }
}

__device__ __forceinline__ void phase_gla_naive(const Params& p, int jl, unsigned char* lds) {
    const bf16_t* PR = (const bf16_t*)(p.ws + WS_B); const float* G1 = (const float*)(p.ws + WS_GATE);
    bf16_t* OF = (bf16_t*)(p.ws + WS_A); bf16_t* OB = (bf16_t*)(p.ws + WS_O2);
    const float* w2 = p.in[9] + (size_t)jl * 2 * 16 * 512; const float* bgk = p.in[10] + (size_t)jl * 2 * 512;
    float* a_s = (float*)lds; float* q_s = a_s + 128; float* k_s = q_s + 128; float* part = k_s + 128;
    const int tid = opaque_tid(), dv = tid & 255, half = tid >> 8;
    for (int ci = blockIdx.x; ci < 288; ci += gridDim.x) {
        int seq, h, e;
        if (ci < 32) { seq = 32 + (ci >> 3); h = (ci >> 1) & 3; e = ci & 1; } else { const int c2 = ci - 32; seq = c2 >> 3; h = (c2 >> 1) & 3; e = c2 & 1; }
        const int L = seq < 32 ? 2048 : 8192, t0 = seq < 32 ? seq * 2048 : NPT + (seq - 32) * 8192;
        float S[64];
#pragma unroll
        for (int i = 0; i < 64; ++i) S[i] = 0.f;
        float w2r[16]; float bg = 0.f;
#pragma unroll
        for (int r = 0; r < 16; ++r) w2r[r] = 0.f;
        if (tid < 128) { bg = bgk[e * 512 + h * 128 + tid];
#pragma unroll
            for (int r = 0; r < 16; ++r) w2r[r] = w2[(e * 16 + r) * 512 + h * 128 + tid]; }
        for (int t = 0; t < L; ++t) {
            const int tok = e == 0 ? t0 + t : t0 + L - 1 - t;
            if (tid < 128) {
                float g = bg; const f32x4* gp = (const f32x4*)(G1 + (size_t)tok * 32 + e * 16);
#pragma unroll
                for (int r4 = 0; r4 < 4; ++r4) { const f32x4 gv = gp[r4]; g += gv[0] * w2r[4 * r4] + gv[1] * w2r[4 * r4 + 1] + gv[2] * w2r[4 * r4 + 2] + gv[3] * w2r[4 * r4 + 3]; }
                const float ls = fminf(g, 0.f) - log1pf(__expf(-fabsf(g)));
                a_s[tid] = __expf(ls * (1.0f / 16.0f));
                q_s[tid] = bf2f(PR[(size_t)tok * 3072 + h * 128 + tid]) * 0.08838834764831845f;
                k_s[tid] = bf2f(PR[(size_t)tok * 3072 + 512 + h * 128 + tid]);
            }
            __syncthreads();
            const float v = bf2f(PR[(size_t)tok * 3072 + 1024 + h * 256 + dv]);
            float acc = 0.f;
#pragma unroll
            for (int i = 0; i < 64; ++i) { const int dk = half * 64 + i; const float a = a_s[dk], kk = k_s[dk], qq = q_s[dk];
                if (e == 0) { S[i] = a * S[i] + kk * v; acc += qq * S[i]; } else { const float sp = a * S[i]; acc += qq * sp; S[i] = sp + kk * v; } }
            part[half * 256 + dv] = acc;
            __syncthreads();
            if (tid < 256) { const float o = part[dv] + part[256 + dv]; (e == 0 ? OF : OB)[(size_t)tok * 1024 + h * 256 + dv] = f2bf(o); }
        }
        __syncthreads();
    }
}

__device__ __forceinline__ void phase_sgu_naive(const Params& p, int jl, unsigned char* lds) {
    const bf16_t* Z = (const bf16_t*)(p.ws + WS_B); bf16_t* MO = (bf16_t*)(p.ws + WS_A);
    const float* ln_g = p.in[15] + jl * 1024; const float* ln_b = p.in[16] + jl * 1024; const float* w_s = p.in[17] + (size_t)jl * 4 * 128 * 128; const float* b_s = p.in[18] + jl * 4 * 128;
    float* vn = (float*)lds; float* stats = (float*)(lds + 131072);
    const int tid = opaque_tid(), lane = tid & 63, wave = tid >> 6;
    for (int chunk = blockIdx.x; chunk < NTOK / 128; chunk += gridDim.x) {
        const int tok0 = chunk * 128;
        for (int rr = 0; rr < 16; ++rr) { const int row = wave * 16 + rr; const bf16_t* vr = Z + (size_t)(tok0 + row) * 2048 + 1024;
            f32x4 v[4]; float s = 0.f;
#pragma unroll
            for (int j = 0; j < 4; ++j) { v[j] = unpack4(*(const u32x2*)(vr + 256 * j + 4 * lane)); s += (v[j][0] + v[j][1]) + (v[j][2] + v[j][3]); }
            const float mean = wave_sum(s) * (1.0f / 1024.0f); float q = 0.f;
#pragma unroll
            for (int j = 0; j < 4; ++j) { const f32x4 d = v[j] - mean; q += (d[0] * d[0] + d[1] * d[1]) + (d[2] * d[2] + d[3] * d[3]); }
            const float rstd = rsqrtf(wave_sum(q) * (1.0f / 1024.0f) + EPS);
            if (lane == 0) { stats[row * 2] = mean; stats[row * 2 + 1] = rstd; } }
        __syncthreads();
        for (int g = 0; g < 4; ++g) {
            for (int e = tid; e < 128 * 256; e += 512) { const int s = e >> 8, d = e & 255;
                vn[s * 256 + d] = (bf2f(Z[(size_t)(tok0 + s) * 2048 + 1024 + g * 256 + d]) - stats[s * 2]) * stats[s * 2 + 1] * ln_g[g * 256 + d] + ln_b[g * 256 + d]; }
            __syncthreads();
            const int d = tid & 255, th = tid >> 8;
            for (int t = th * 64; t < th * 64 + 64; ++t) {
                const float* wrow = w_s + (size_t)(g * 128 + t) * 128; float acc = 0.f;
#pragma unroll 8
                for (int s = 0; s < 128; ++s) acc += wrow[s] * vn[s * 256 + d];
                const float o = acc + b_s[g * 128 + t]; const float u = bf2f(Z[(size_t)(tok0 + t) * 2048 + g * 256 + d]);
                MO[(size_t)(tok0 + t) * 1024 + g * 256 + d] = f2bf(u * o);
            }
            __syncthreads();
        }
    }
}

__device__ __forceinline__ void phase_sgu_mfma(const Params& p, int jl, unsigned char* lds) {
    const bf16_t* Z = (const bf16_t*)(p.ws + WS_B); bf16_t* MO = (bf16_t*)(p.ws + WS_A); const bf16_t* WSB = (const bf16_t*)(p.ws + WS_WS);
    const float* ln_g = p.in[15] + jl * 1024; const float* ln_b = p.in[16] + jl * 1024; const float* b_s = p.in[18] + jl * 4 * 128; const float* wsum = (const float*)(p.ws + WS_WSUM); const float* SP = (const float*)(p.ws + WS_GATE);
    float* stats = (float*)lds;
    unsigned char* wsm = lds + 1024;
    unsigned char* vT = lds + 1024 + 128 * 272;
    const int tid = opaque_tid(), lane = tid & 63, wave = __builtin_amdgcn_readfirstlane(tid >> 6), fr = lane & 15, fq = lane >> 4;
    for (int chunk = blockIdx.x; chunk < NTOK / 128; chunk += gridDim.x) {
        const int tok0 = chunk * 128;
        if (tid < 128) { const f32x4* sp = (const f32x4*)(SP + (size_t)(tok0 + tid) * 32); float s1 = 0.f, s2 = 0.f;
#pragma unroll
            for (int i = 0; i < 8; ++i) { const f32x4 v = sp[i]; s1 += v[0] + v[2]; s2 += v[1] + v[3]; }
            const float mean = s1 * (1.0f / 1024.0f), var = fmaxf(s2 * (1.0f / 1024.0f) - mean * mean, 0.f);
            stats[tid * 2] = mean; stats[tid * 2 + 1] = rsqrtf(var + EPS); }
        __syncthreads();
        const int srow = lane + 64 * (wave & 1);
        const float mean = stats[srow * 2], rstd = stats[srow * 2 + 1];
        for (int g = 0; g < 4; ++g) {
#pragma unroll
            for (int i = 0; i < 4; ++i) { const int e = tid + 512 * i, t = e >> 4, c16 = e & 15;
                *(u32x4*)(wsm + t * 272 + c16 * 16) = *(const u32x4*)(WSB + (size_t)(g * 128 + t) * 128 + c16 * 8); }
            { u32x4 raw[8];
#pragma unroll
              for (int i = 0; i < 8; ++i) raw[i] = *(const u32x4*)(Z + (size_t)(tok0 + srow) * 2048 + 1024 + g * 256 + ((wave >> 1) + 4 * i) * 8);
#pragma unroll
              for (int i = 0; i < 8; ++i) { const int dblk = (wave >> 1) + 4 * i;
                const f32x4 x0 = unpack4((u32x2){raw[i].x, raw[i].y}), x1 = unpack4((u32x2){raw[i].z, raw[i].w});
                const f32x4 y0 = (x0 - mean) * rstd, y1 = (x1 - mean) * rstd;
                const unsigned p0 = pk2(y0[0], y0[1]), p1 = pk2(y0[2], y0[3]), p2 = pk2(y1[0], y1[1]), p3 = pk2(y1[2], y1[3]);
                bf16_t* dst = (bf16_t*)(vT + (dblk * 8) * 272 + srow * 2);
                dst[0 * 136] = (bf16_t)(p0 & 0xffffu); dst[1 * 136] = (bf16_t)(p0 >> 16); dst[2 * 136] = (bf16_t)(p1 & 0xffffu); dst[3 * 136] = (bf16_t)(p1 >> 16);
                dst[4 * 136] = (bf16_t)(p2 & 0xffffu); dst[5 * 136] = (bf16_t)(p2 >> 16); dst[6 * 136] = (bf16_t)(p3 & 0xffffu); dst[7 * 136] = (bf16_t)(p3 >> 16); } }
            __syncthreads();
            f32x4 acc[2][8];
#pragma unroll
            for (int dt = 0; dt < 2; ++dt)
#pragma unroll
                for (int tt = 0; tt < 8; ++tt) acc[dt][tt] = (f32x4){0.f, 0.f, 0.f, 0.f};
#pragma unroll
            for (int ks = 0; ks < 4; ++ks) {
                bf16x8 af[2];
#pragma unroll
                for (int dt = 0; dt < 2; ++dt) af[dt] = *(const bf16x8*)(vT + (wave * 32 + 8 * (fr >> 2) + 4 * dt + (fr & 3)) * 272 + (ks * 32 + fq * 8) * 2);
#pragma unroll
                for (int tt = 0; tt < 8; ++tt) { const bf16x8 bf = *(const bf16x8*)(wsm + (tt * 16 + fr) * 272 + (ks * 32 + fq * 8) * 2);
#pragma unroll
                    for (int dt = 0; dt < 2; ++dt) acc[dt][tt] = __builtin_amdgcn_mfma_f32_16x16x32_bf16(af[dt], bf, acc[dt][tt], 0, 0, 0); }
            }
            { const int col = g * 256 + wave * 32 + 8 * fq;
              f32x4 lg[2], lb[2];
#pragma unroll
              for (int dt = 0; dt < 2; ++dt) { lg[dt] = *(const f32x4*)(ln_g + col + 4 * dt); lb[dt] = *(const f32x4*)(ln_b + col + 4 * dt); }
              u32x4 uraw[8];
#pragma unroll
              for (int tt = 0; tt < 8; ++tt) uraw[tt] = *(const u32x4*)(Z + (size_t)(tok0 + tt * 16 + fr) * 2048 + col);
#pragma unroll
              for (int tt = 0; tt < 8; ++tt) { const int t = tt * 16 + fr; const float bs = b_s[g * 128 + t], wsm_t = wsum[g * 128 + t];
                const f32x4 u0 = unpack4((u32x2){uraw[tt].x, uraw[tt].y}), u1 = unpack4((u32x2){uraw[tt].z, uraw[tt].w});
                const f32x4 o0 = (acc[0][tt] * lg[0] + (lb[0] * wsm_t + bs)) * u0, o1 = (acc[1][tt] * lg[1] + (lb[1] * wsm_t + bs)) * u1;
                *(u32x4*)(MO + (size_t)(tok0 + t) * 1024 + col) = (u32x4){pk2(o0[0], o0[1]), pk2(o0[2], o0[3]), pk2(o1[0], o1[1]), pk2(o1[2], o1[3])}; } }
            __syncthreads();
        }
    }
}

#define LDS_BARRIER() do { asm volatile("s_waitcnt lgkmcnt(0)" ::: "memory"); __builtin_amdgcn_s_barrier(); asm volatile("" ::: "memory"); } while (0)
typedef float f32x2 __attribute__((ext_vector_type(2)));
__device__ __forceinline__ f32x2 ex2v(f32x2 x) { f32x2 r; r.x = __builtin_amdgcn_exp2f(x.x); r.y = __builtin_amdgcn_exp2f(x.y); return r; }
template <int DKH, int DVW>
__device__ __forceinline__ void gla_chain(const Params& p, int jl, unsigned char* lds, int seq, int h, int e, int dk0, int dv0, bf16_t* OUTB, int ostride, int orow_off) {
    constexpr int PAIRS = DKH / 2, NSEG = 512 / PAIRS, NP = 64 / NSEG, KS = DKH / 32, DKT = DKH / 16, DT = DVW / 16, NV = DVW / 8;
    const bf16_t* PR = (const bf16_t*)(p.ws + WS_B); const float* G1 = (const float*)(p.ws + WS_GATE);
    const float* w2 = p.in[9] + (size_t)jl * 2 * 16 * 512; const float* bgk = p.in[10] + (size_t)jl * 2 * 512;
    const int tid = opaque_tid(), lane = tid & 63, wave = __builtin_amdgcn_readfirstlane(tid >> 6), fr = lane & 15, fq = lane >> 4;
    const int dkp = lane & (PAIRS - 1), seg = DKH == 128 ? wave : wave * 2 + (lane >> 5);
    float* g1s = (float*)lds; float* segtot = (float*)(lds + 8192); float* decs = (float*)(lds + 12288);
    float* w2s = (float*)(lds + 112640);
    unsigned char* qd = lds + 13312; unsigned char* kd = lds + 30720; unsigned char* keT = lds + 48128; unsigned char* sc = lds + 66560; unsigned char* vTw = lds + 75776 + wave * 4608;
    const float LOG2E = 1.4426950408889634f, QSCALE = 0.08838834764831845f;
    const int gc = tid >> 2, gr4 = tid & 3;
    {
        const int L = seq < 32 ? 2048 : 8192, t0 = seq < 32 ? seq * 2048 : NPT + (seq - 32) * 8192, nch = L >> 6;
        f32x4 Sacc[DKT][DT];
#pragma unroll
        for (int a = 0; a < DKT; ++a)
#pragma unroll
            for (int dt = 0; dt < DT; ++dt) Sacc[a][dt] = (f32x4){0.f, 0.f, 0.f, 0.f};
        const f32x2 bg = *(const f32x2*)(bgk + e * 512 + h * 128 + dk0 + 2 * dkp);
        for (int i = tid; i < 16 * DKH; i += 512) w2s[i] = w2[(e * 16 + i / DKH) * 512 + h * 128 + dk0 + (i % DKH)];
        unsigned qraw[NP], kraw[NP]; u32x4 vraw[NV]; f32x4 g1n = (f32x4){0.f, 0.f, 0.f, 0.f};
#define GLA_LOAD_CHUNK(tk0) do { \
            const bf16_t* qp_ = PR + (size_t)((tk0) + seg * NP) * 3072 + h * 128 + dk0 + 2 * dkp; \
            _Pragma("unroll") for (int i = 0; i < NP; ++i) { qraw[i] = *(const unsigned*)(qp_ + (size_t)i * 3072); kraw[i] = *(const unsigned*)(qp_ + (size_t)i * 3072 + 512); } \
            const bf16_t* vp_ = PR + (size_t)((tk0) + lane) * 3072 + 1024 + h * 256 + dv0 + wave * DVW; \
            _Pragma("unroll") for (int jv = 0; jv < NV; ++jv) vraw[jv] = *(const u32x4*)(vp_ + 8 * jv); \
            } while (0)
#define GLA_LOAD_G1(tk0) do { if (tid < 256) g1n = *(const f32x4*)(G1 + (size_t)((tk0) + gc) * 32 + e * 16 + gr4 * 4); } while (0)
        { const int tk = t0 + (e == 0 ? 0 : nch - 1) * 64; GLA_LOAD_G1(tk); }
        if (tid < 256) *(f32x4*)(g1s + gc * 16 + gr4 * 4) = g1n;
        LDS_BARRIER();
        for (int n = 0; n < nch; ++n) {
            const int cn = e == 0 ? n : nch - 1 - n, tokc0 = t0 + cn * 64;
            const float* g1cur = g1s + (n & 1) * 1024; float* g1nxt = g1s + ((n + 1) & 1) * 1024;
            GLA_LOAD_CHUNK(tokc0);
            if (n + 1 < nch) { const int tk = t0 + (e == 0 ? n + 1 : nch - 2 - n) * 64; GLA_LOAD_G1(tk); }
            f32x2 bl[NP]; f32x2 w2r[16];
#pragma unroll
            for (int r = 0; r < 16; ++r) w2r[r] = *(const f32x2*)(w2s + r * DKH + 2 * dkp);
#pragma unroll
            for (int i = 0; i < NP; ++i) { const f32x4* gp = (const f32x4*)(g1cur + (seg * NP + i) * 16); f32x2 g = bg;
#pragma unroll
                for (int r4 = 0; r4 < 4; ++r4) { const f32x4 gv = gp[r4]; g += w2r[4 * r4] * gv[0]; g += w2r[4 * r4 + 1] * gv[1]; g += w2r[4 * r4 + 2] * gv[2]; g += w2r[4 * r4 + 3] * gv[3]; }
                const f32x2 ag = __builtin_elementwise_abs(g) * (-LOG2E); f32x2 t; t.x = __builtin_amdgcn_logf(1.0f + __builtin_amdgcn_exp2f(ag.x)); t.y = __builtin_amdgcn_logf(1.0f + __builtin_amdgcn_exp2f(ag.y));
                const f32x2 mg = __builtin_elementwise_min(g, (f32x2){0.f, 0.f});
                bl[i] = (mg * LOG2E - t) * (1.0f / 16.0f); }
            if (e == 0) {
#pragma unroll
                for (int i = 1; i < NP; ++i) bl[i] += bl[i - 1];
            } else {
#pragma unroll
                for (int i = NP - 2; i >= 0; --i) bl[i] += bl[i + 1];
            }
            *(f32x2*)(segtot + seg * DKH + 2 * dkp) = e == 0 ? bl[NP - 1] : bl[0];
            LDS_BARRIER();
            f32x2 off = (f32x2){0.f, 0.f}, tot = (f32x2){0.f, 0.f};
#pragma unroll
            for (int s = 0; s < NSEG; ++s) { const f32x2 sv = *(const f32x2*)(segtot + s * DKH + 2 * dkp); tot += sv; const bool inc = e == 0 ? (s < seg) : (s > seg); off += inc ? sv : (f32x2){0.f, 0.f}; }
            const f32x2 dec = ex2v(tot);
            if (seg == 0) *(f32x2*)(decs + 2 * dkp) = dec;
            f32x2 ke[NP];
#pragma unroll
            for (int i = 0; i < NP; ++i) { const f32x2 b = bl[i] + off; const f32x2 eb = ex2v(b), enb = ex2v(-b);
                const f32x2 qf = (f32x2){__uint_as_float(qraw[i] << 16), __uint_as_float(qraw[i] & 0xffff0000u)} * QSCALE * eb;
                const f32x2 kf = (f32x2){__uint_as_float(kraw[i] << 16), __uint_as_float(kraw[i] & 0xffff0000u)} * enb;
                *(unsigned*)(qd + (seg * NP + i) * 272 + dkp * 4) = pk2(qf.x, qf.y);
                *(unsigned*)(kd + (seg * NP + i) * 272 + dkp * 4) = pk2(kf.x, kf.y);
                ke[i] = kf * dec; }
            if constexpr (NP == 8) { u32x4 w0, w1; w0.x = pk2(ke[0].x, ke[1].x); w0.y = pk2(ke[2].x, ke[3].x); w0.z = pk2(ke[4].x, ke[5].x); w0.w = pk2(ke[6].x, ke[7].x);
              w1.x = pk2(ke[0].y, ke[1].y); w1.y = pk2(ke[2].y, ke[3].y); w1.z = pk2(ke[4].y, ke[5].y); w1.w = pk2(ke[6].y, ke[7].y);
              *(u32x4*)(keT + (2 * dkp) * 144 + seg * 16) = w0; *(u32x4*)(keT + (2 * dkp + 1) * 144 + seg * 16) = w1; }
            else { u32x2 w0, w1; w0.x = pk2(ke[0].x, ke[1].x); w0.y = pk2(ke[2].x, ke[3].x); w1.x = pk2(ke[0].y, ke[1].y); w1.y = pk2(ke[2].y, ke[3].y);
              *(u32x2*)(keT + (2 * dkp) * 144 + seg * 8) = w0; *(u32x2*)(keT + (2 * dkp + 1) * 144 + seg * 8) = w1; }
#pragma unroll
            for (int jv = 0; jv < NV; ++jv) { const unsigned wd[4] = {vraw[jv].x, vraw[jv].y, vraw[jv].z, vraw[jv].w};
#pragma unroll
                for (int k2 = 0; k2 < 4; ++k2) { *(bf16_t*)(vTw + (jv * 8 + 2 * k2) * 144 + lane * 2) = (bf16_t)(wd[k2] & 0xffffu); *(bf16_t*)(vTw + (jv * 8 + 2 * k2 + 1) * 144 + lane * 2) = (bf16_t)(wd[k2] >> 16); } }
            LDS_BARRIER();
            { const int st = wave >> 1, ct0 = (wave & 1) * 2;
              bf16x8 Af[KS], Bf[2][KS];
#pragma unroll
              for (int ks = 0; ks < KS; ++ks) { Af[ks] = *(const bf16x8*)(kd + (st * 16 + fr) * 272 + (ks * 32 + fq * 8) * 2);
                  Bf[0][ks] = *(const bf16x8*)(qd + (ct0 * 16 + fr) * 272 + (ks * 32 + fq * 8) * 2); Bf[1][ks] = *(const bf16x8*)(qd + ((ct0 + 1) * 16 + fr) * 272 + (ks * 32 + fq * 8) * 2); }
              __builtin_amdgcn_sched_barrier(0);
              f32x4 a0 = (f32x4){0.f, 0.f, 0.f, 0.f}, a1 = a0;
#pragma unroll
              for (int ks = 0; ks < KS; ++ks) { a0 = __builtin_amdgcn_mfma_f32_16x16x32_bf16(Af[ks], Bf[0][ks], a0, 0, 0, 0); a1 = __builtin_amdgcn_mfma_f32_16x16x32_bf16(Af[ks], Bf[1][ks], a1, 0, 0, 0); }
              const int sb = st * 16 + fq * 4;
#pragma unroll
              for (int tix = 0; tix < 2; ++tix) { const int c = (ct0 + tix) * 16 + fr; f32x4 a = tix == 0 ? a0 : a1;
#pragma unroll
                  for (int i = 0; i < 4; ++i) { const bool keep = e == 0 ? (sb + i <= c) : (sb + i > c); a[i] = keep ? a[i] : 0.f; }
                  u32x2 w; w.x = pk2(a[0], a[1]); w.y = pk2(a[2], a[3]);
                  *(u32x2*)(sc + c * 144 + sb * 2) = w; } }
            LDS_BARRIER();
            bf16x8 vf[DT][2];
#pragma unroll
            for (int dt = 0; dt < DT; ++dt)
#pragma unroll
                for (int ks = 0; ks < 2; ++ks) vf[dt][ks] = *(const bf16x8*)(vTw + (dt * 16 + fr) * 144 + (ks * 32 + fq * 8) * 2);
            f32x4 o[DT][4];
            { bf16x8 Bs[2][4];
#pragma unroll
              for (int ks = 0; ks < 2; ++ks)
#pragma unroll
                  for (int ct = 0; ct < 4; ++ct) Bs[ks][ct] = *(const bf16x8*)(sc + (ct * 16 + fr) * 144 + (ks * 32 + fq * 8) * 2);
              bf16x8 Sbf[KS][DT];
#pragma unroll
              for (int ks = 0; ks < KS; ++ks)
#pragma unroll
                  for (int dt = 0; dt < DT; ++dt) { const f32x4 x0 = Sacc[2 * ks][dt], x1 = Sacc[2 * ks + 1][dt];
                      const u32x4 w = (u32x4){pk2(x0[0], x0[1]), pk2(x0[2], x0[3]), pk2(x1[0], x1[1]), pk2(x1[2], x1[3])}; Sbf[ks][dt] = __builtin_bit_cast(bf16x8, w); }
              u32x4 Bq[2][4];
#define GLA_LDQ(buf, ks_) do { _Pragma("unroll") for (int ct = 0; ct < 4; ++ct) { \
                  const u32x2 lo_ = *(const u32x2*)(qd + (ct * 16 + fr) * 272 + ((ks_) * 32 + fq * 4) * 2), hi_ = *(const u32x2*)(qd + (ct * 16 + fr) * 272 + ((ks_) * 32 + 16 + fq * 4) * 2); \
                  Bq[buf][ct] = (u32x4){lo_.x, lo_.y, hi_.x, hi_.y}; } } while (0)
              GLA_LDQ(0, 0);
              __builtin_amdgcn_sched_barrier(0);
#pragma unroll
              for (int ct = 0; ct < 4; ++ct)
#pragma unroll
                  for (int dt = 0; dt < DT; ++dt) o[dt][ct] = __builtin_amdgcn_mfma_f32_16x16x32_bf16(vf[dt][0], Bs[0][ct], (f32x4){0.f, 0.f, 0.f, 0.f}, 0, 0, 0);
#pragma unroll
              for (int ct = 0; ct < 4; ++ct)
#pragma unroll
                  for (int dt = 0; dt < DT; ++dt) o[dt][ct] = __builtin_amdgcn_mfma_f32_16x16x32_bf16(vf[dt][1], Bs[1][ct], o[dt][ct], 0, 0, 0);
#pragma unroll
              for (int ks = 0; ks < KS; ++ks) {
                  if (ks < KS - 1) GLA_LDQ((ks + 1) & 1, ks + 1);
                  __builtin_amdgcn_sched_barrier(0);
#pragma unroll
                  for (int ct = 0; ct < 4; ++ct) { const bf16x8 B = __builtin_bit_cast(bf16x8, Bq[ks & 1][ct]);
#pragma unroll
                      for (int dt = 0; dt < DT; ++dt) o[dt][ct] = __builtin_amdgcn_mfma_f32_16x16x32_bf16(Sbf[ks][dt], B, o[dt][ct], 0, 0, 0); }
                  __builtin_amdgcn_sched_barrier(0);
              }
#undef GLA_LDQ
            }
#pragma unroll
            for (int ct = 0; ct < 4; ++ct)
#pragma unroll
                for (int dt = 0; dt < DT; ++dt) { u32x2 w; w.x = pk2(o[dt][ct][0], o[dt][ct][1]); w.y = pk2(o[dt][ct][2], o[dt][ct][3]);
                    *(u32x2*)(OUTB + (size_t)(tokc0 - orow_off + ct * 16 + fr) * ostride + h * 256 + dv0 + wave * DVW + dt * 16 + fq * 4) = w; }
            { bf16x8 Ak[2][2][2]; f32x4 dcv[2][2];
#define GLA_LDK(buf, g_) do { _Pragma("unroll") for (int d2 = 0; d2 < 2; ++d2) { dcv[buf][d2] = *(const f32x4*)(decs + ((g_) * 2 + d2) * 16 + fq * 4); \
                  _Pragma("unroll") for (int ks = 0; ks < 2; ++ks) Ak[buf][d2][ks] = *(const bf16x8*)(keT + (((g_) * 2 + d2) * 16 + fr) * 144 + (ks * 32 + fq * 8) * 2); } } while (0)
              GLA_LDK(0, 0);
#pragma unroll
              for (int g = 0; g < DKT / 2; ++g) {
                  if (g < DKT / 2 - 1) GLA_LDK((g + 1) & 1, g + 1);
                  __builtin_amdgcn_sched_barrier(0);
#pragma unroll
                  for (int d2 = 0; d2 < 2; ++d2) { const int dkt = g * 2 + d2;
#pragma unroll
                      for (int dt = 0; dt < DT; ++dt) Sacc[dkt][dt] *= dcv[g & 1][d2];
#pragma unroll
                      for (int ks = 0; ks < 2; ++ks)
#pragma unroll
                          for (int dt = 0; dt < DT; ++dt) Sacc[dkt][dt] = __builtin_amdgcn_mfma_f32_16x16x32_bf16(Ak[g & 1][d2][ks], vf[dt][ks], Sacc[dkt][dt], 0, 0, 0); }
                  __builtin_amdgcn_sched_barrier(0);
              }
#undef GLA_LDK
            }
            if (tid < 256 && n + 1 < nch) *(f32x4*)(g1nxt + gc * 16 + gr4 * 4) = g1n;
            LDS_BARRIER();
        }
#undef GLA_LOAD_CHUNK
#undef GLA_LOAD_G1
    }
}

__device__ __forceinline__ void phase_gla_mfma(const Params& p, int jl, unsigned char* lds) {
    const int G = gridDim.x, bx = blockIdx.x;
    int idx = bx, round = 0;
    while (idx < 384) {
        if (idx < 128) { const int chain = idx >> 2, half = (idx >> 1) & 1, dvh = idx & 1, seq = 32 + (chain >> 3), h = (chain >> 1) & 3, e = chain & 1;
            bf16_t* ob; int ostride, ooff;
            if (half == 0) { ob = (bf16_t*)(p.ws + (e == 0 ? WS_A : WS_O2)); ostride = 1024; ooff = 0; }
            else { ob = (bf16_t*)p.out + 1024; ostride = 2048; ooff = e == 0 ? 0 : NPT; }
            gla_chain<64, 16>(p, jl, lds, seq, h, e, half * 64, dvh * 128, ob, ostride, ooff);
        } else { const int c2 = idx - 128, seq = c2 >> 3, h = (c2 >> 1) & 3, e = c2 & 1;
            gla_chain<128, 32>(p, jl, lds, seq, h, e, 0, 0, (bf16_t*)(p.ws + (e == 0 ? WS_A : WS_O2)), 1024, 0);
        }
        ++round;
        if (G == 256) idx = (round == 1 && bx >= 128) ? 128 + bx : 384; else idx += G;
    }
}
#define GLA_PHASE phase_gla_mfma
#define SGU_PHASE phase_sgu_mfma

__global__ void __launch_bounds__(512, 2) fwd_kernel(Params p) {
    extern __shared__ __attribute__((aligned(16))) unsigned char lds[];
    cg::grid_group grid = cg::this_grid();
    const int G = gridDim.x;
    { volatile LAS unsigned* st0 = (volatile LAS unsigned*)((LAS unsigned char*)lds + 132096); if (threadIdx.x < 4) st0[threadIdx.x] = 0u; }
    __syncthreads();
    XcdBarrier bar = xcd_barrier_post((unsigned*)(p.ws + WS_BAR), (volatile LAS unsigned*)((LAS unsigned char*)lds + 132096));
    PG8_LAS unsigned char* glds = (PG8_LAS unsigned char*)lds;
#define RA ((bf16_t*)(p.ws + WS_A))
#define RO2 ((bf16_t*)(p.ws + WS_O2))
#define RB ((bf16_t*)(p.ws + WS_B))
#define W1 ((const bf16_t*)(p.ws + WS_W1))
#define W2 ((const bf16_t*)(p.ws + WS_W2))
#define W3 ((const bf16_t*)(p.ws + WS_W3))
#define W4 ((const bf16_t*)(p.ws + WS_W4))

#ifndef NO_MOD
    phase_mod(p, lds);
#endif
    grid.sync();
    for (int l = 0; l < 4; ++l) {
        const bool gla = (l & 1) == 0; const int jl = l >> 1;
#ifndef NO_CONV
        phase_convert(p, l, lds);
#endif
#ifndef NO_ELEM
        if (l == 0) phase_elem<0>(p,   false, -1, 5, 3,   0,   true, 0, 0, 0);
        else phase_elem<1>(p, true, l - 1, 5, 3, 1, true, l, 0, 0);
#endif
        xcd_barrier(bar);
        for (int gs = 0; gs < 4; ++gs) {
#ifndef NO_MIX
            if (gs == 1) {
                if (gla) { GLA_PHASE(p, jl, lds);
#ifdef PROBE_GLA2
                    GLA_PHASE(p, jl, lds);
#endif
                    xcd_barrier(bar); phase_gla_combine(p, jl); xcd_barrier(bar); }
                else { SGU_PHASE(p, jl, lds);
#ifdef PROBE_SGU2
                    SGU_PHASE(p, jl, lds);
#endif
                    xcd_barrier(bar); }
            }
#endif
#ifndef NO_ELEM
            if (gs == 2) { if (l == 0) phase_elem<0>(p, true, 0, 2, 1, 1, true, 0, 3, 2); else phase_elem<1>(p, true, l, 2, 1, 1, true, l, 3, 2); xcd_barrier(bar); }
#endif
            if (gs == 0 && !gla) {
                pg8::Gemm g{RA, W1, NTOK, 2048, 1024}; pg8::StaticOrder S; S.init(NTOK, 2048, G, (int)blockIdx.x);
                pg8::EpiGelu E{RB, 2048, p.in[14] + jl * 2048, (float*)(p.ws + WS_GATE), 1024};
#ifndef NO_GB
                pg8::gemm_phase<pg8::EpiGelu, pg8::StaticOrder, true, true>(glds, g, S, E);
#ifdef PROBE_GEMM2
                pg8::gemm_phase<pg8::EpiGelu, pg8::StaticOrder, true, true>(glds, g, S, E);
#endif
#endif
            } else if (gs == 2) {
                pg8::Gemm g{RA, W3, NTOK, 5632, 1024}; pg8::StaticOrder S; S.init(NTOK, 5632, G, (int)blockIdx.x);
                pg8::EpiSwiGLU E{RB, FFH};
#ifndef NO_GC
                pg8::gemm_phase<pg8::EpiSwiGLU, pg8::StaticOrder, true, true>(glds, g, S, E);
#ifdef PROBE_GEMM2
                pg8::gemm_phase<pg8::EpiSwiGLU, pg8::StaticOrder, true, true>(glds, g, S, E);
#endif
#endif
            } else {
                pg8::Gemm g; pg8::EpiPlain E;
                if (gs == 0)      { g = pg8::Gemm{RA, W1, NTOK, 3328, 1024}; E = pg8::EpiPlain{RB, 3072, 3072, (float*)(p.ws + WS_GATE)}; }
                else if (gs == 1) { g = pg8::Gemm{RA, W2, NTOK, 1024, 1024}; E = pg8::EpiPlain{RO2, 1024, 1024, nullptr}; }
                else              { g = pg8::Gemm{RB, W4, NTOK, 1024, FFH};  E = pg8::EpiPlain{RO2, 1024, 1024, nullptr}; }
                pg8::StaticOrder S; S.init(g.M, g.N, G, (int)blockIdx.x);
#ifndef NO_GA
                pg8::gemm_phase<pg8::EpiPlain, pg8::StaticOrder, true, true>(glds, g, S, E);
#ifdef PROBE_GEMM2
                pg8::gemm_phase<pg8::EpiPlain, pg8::StaticOrder, true, true>(glds, g, S, E);
#endif
#endif
            }
            xcd_barrier(bar);
        }
    }
#ifndef NO_ELEM
    phase_elem<1>(p, true, 3, 5, 3, 2, false, 0, 0, 0);
#endif
}

extern "C" void kernel_launch(void* const* d_in, const int* in_sizes, int n_in, void* d_out, int out_size, void* d_ws, size_t ws_size, hipStream_t stream) {
    static int grid = 0;
    if (grid == 0) {
        if (n_in != 22 || out_size != NTOK * D || ws_size < WS_END) { fprintf(stderr, "kernel_launch: unexpected shapes: n_in %d out %d ws %zu (need %zu)\n", n_in, out_size, ws_size, (size_t)WS_END); grid = -1; return; }
        int dev = 0, cus = 0, per_cu = 0;
        if (hipGetDevice(&dev) != hipSuccess || hipDeviceGetAttribute(&cus, hipDeviceAttributeMultiprocessorCount, dev) != hipSuccess) { grid = -1; return; }
        if (hipFuncSetAttribute((const void*)fwd_kernel, hipFuncAttributeMaxDynamicSharedMemorySize, LDS_BYTES) != hipSuccess) { fprintf(stderr, "kernel_launch: hipFuncSetAttribute failed\n"); grid = -1; return; }
        if (hipOccupancyMaxActiveBlocksPerMultiprocessor(&per_cu, (const void*)fwd_kernel, 512, LDS_BYTES) != hipSuccess || per_cu < 1) { fprintf(stderr, "kernel_launch: occupancy query says %d\n", per_cu); per_cu = 1; }
        (void)hipGetLastError();
        grid = cus * 1;
    }
    if (grid < 0) return;
    if (hipMemsetAsync((char*)d_ws + WS_BAR, 0, 16384, stream) != hipSuccess) { fprintf(stderr, "kernel_launch: memset of the barrier words failed\n"); return; }
    Params p{};
    for (int i = 0; i < 22; ++i) p.in[i] = (const float*)d_in[i];
    p.out = (float*)d_out; p.ws = (unsigned char*)d_ws;
    void* args[] = {&p};
    hipError_t e = hipLaunchCooperativeKernel((const void*)fwd_kernel, dim3(grid), dim3(512), args, LDS_BYTES, stream);
    if (e != hipSuccess) fprintf(stderr, "cooperative launch failed: %s (grid %d)\n", hipGetErrorString(e), grid);
}
```

```cpp
#include <hip/hip_runtime.h>
#include <hip/hip_cooperative_groups.h>
#include <cstdio>
#include <cstdint>
namespace cg = cooperative_groups;

namespace pg8 {
#define PG8_LAS __attribute__((address_space(3)))
typedef unsigned short bf16_t;
typedef short bf16x8 __attribute__((ext_vector_type(8)));
typedef float f32x4 __attribute__((ext_vector_type(4)));
typedef unsigned u32x4 __attribute__((ext_vector_type(4)));
constexpr int BM = 256, BK = 64, HALF = 128, HTB = HALF * BK * 2  , STAGE_BYTES = 8 * HTB, NXCD = 8, WGM = 8;

__host__ __device__ __forceinline__ int lds_byte(int r, int c) { const int st = (r >> 4) * 2 + (c >> 5), rr = r & 15, cc = c & 31, ob = rr * 64 + cc * 2; return st * 1024 + (ob ^ (((ob >> 9) & 1) << 5)); }
__host__ __device__ __forceinline__ void stage_rc(int b, int& R, int& C) { const int st = b / 1024, sb = b % 1024, swz = sb ^ (((sb >> 9) & 1) << 5); R = (st >> 1) * 16 + swz / 64; C = (st & 1) * 32 + (swz % 64) / 2; }
__host__ __device__ __forceinline__ int perm32(int rho) { const int n = rho >> 4, i = rho & 15; return 8 * (i >> 2) + 4 * n + (i & 3); }

struct Unit { int pm, pn; };
struct Gemm { const bf16_t* A; const bf16_t* Bt; int M, N, K; };

struct StaticOrder {
    int nM, nN, nwg, G, c;
    __host__ __device__ void init(int M, int N, int G_, int c_) { nM = M / BM; nN = N / BM; nwg = nM * nN; G = G_; c = c_; }
    __host__ __device__ bool next(int i, Unit& u) const {
        const long L = (long)i * G + c; if (L >= nwg) return false;
        int wgid = (int)L; { const int q = nwg / NXCD, r = nwg % NXCD, xcd = wgid % NXCD, off = wgid / NXCD; wgid = (xcd < r ? xcd * (q + 1) : r * (q + 1) + (xcd - r) * q) + off; }
        const int nig = WGM * nN, gid = wgid / nig, fm = gid * WGM, gsz = (nM - fm) < WGM ? (nM - fm) : WGM;
        u.pm = fm + ((wgid % nig) % gsz); u.pn = (wgid % nig) / gsz; return true;
    }
    __device__ __forceinline__ void a_ready(const Unit&) const {}
    __device__ __forceinline__ void done(const Unit&) const {}
};


__device__ __forceinline__ unsigned cvt_pk_bf16(float lo, float hi) { unsigned r; asm volatile("v_cvt_pk_bf16_f32 %0, %1, %2" : "=v"(r) : "v"(lo), "v"(hi)); return r; }
__device__ __forceinline__ float gelu_tanh(float x) { const float u = 0.7978845608028654f * (x + 0.044715f * x * x * x); return x * __builtin_amdgcn_rcpf(1.0f + __builtin_amdgcn_exp2f(-2.885390081777927f * u)); }
__device__ __forceinline__ float silu_f(float a) { return a * __builtin_amdgcn_rcpf(1.0f + __builtin_amdgcn_exp2f(-1.4426950408889634f * a)); }

struct EpiPlain {
    static constexpr bool PERM = true, AFTER_DRAIN = false;
    bf16_t* O; int ldc; int ncols; float* gate;
    __device__ __forceinline__ void operator()(const f32x4 (&acc)[2][2][4][2], const Unit& u, int wr, int wc, int fr, int fq) const {
        const int row0 = u.pm * BM + wr * 64 + fr; const int colt = u.pn * BM;
        if (colt < ncols) {
            const int col0 = colt + wc * 32 + 8 * fq;
#pragma unroll
            for (int ai = 0; ai < 2; ++ai)
#pragma unroll
                for (int m = 0; m < 4; ++m) { bf16_t* rowp = O + (size_t)(row0 + ai * HALF + m * 16) * ldc + col0;
#pragma unroll
                    for (int bj = 0; bj < 2; ++bj) { const f32x4 v0 = acc[ai][bj][m][0], v1 = acc[ai][bj][m][1];
                        u32x4 w; w.x = cvt_pk_bf16(v0[0], v0[1]); w.y = cvt_pk_bf16(v0[2], v0[3]); w.z = cvt_pk_bf16(v1[0], v1[1]); w.w = cvt_pk_bf16(v1[2], v1[3]);
                        *(u32x4*)(rowp + bj * HALF) = w; } }
        } else if (wc == 0) {
#pragma unroll
            for (int ai = 0; ai < 2; ++ai)
#pragma unroll
                for (int m = 0; m < 4; ++m) { float* gp = gate + (size_t)(row0 + ai * HALF + m * 16) * 32 + 8 * fq;
                    *(f32x4*)gp = acc[ai][0][m][0]; *(f32x4*)(gp + 4) = acc[ai][0][m][1]; }
        }
    }
};
struct EpiGelu {
    static constexpr bool PERM = true, AFTER_DRAIN = false;
    bf16_t* O; int ldc; const float* bias; float* stats; int stat_col0;
    __device__ __forceinline__ void operator()(const f32x4 (&acc)[2][2][4][2], const Unit& u, int wr, int wc, int fr, int fq) const {
        const int row0 = u.pm * BM + wr * 64 + fr; const int col0 = u.pn * BM + wc * 32 + 8 * fq;
        f32x4 bv[2][2];
#pragma unroll
        for (int bj = 0; bj < 2; ++bj)
#pragma unroll
            for (int n = 0; n < 2; ++n) bv[bj][n] = *(const f32x4*)(bias + col0 + bj * HALF + 4 * n);
#pragma unroll
        for (int ai = 0; ai < 2; ++ai)
#pragma unroll
            for (int m = 0; m < 4; ++m) { bf16_t* rowp = O + (size_t)(row0 + ai * HALF + m * 16) * ldc + col0;
                float s1 = 0.f, s2 = 0.f;
#pragma unroll
                for (int bj = 0; bj < 2; ++bj) { f32x4 v0 = acc[ai][bj][m][0] + bv[bj][0], v1 = acc[ai][bj][m][1] + bv[bj][1];
#pragma unroll
                    for (int i = 0; i < 4; ++i) { v0[i] = gelu_tanh(v0[i]); v1[i] = gelu_tanh(v1[i]); }
                    s1 += ((v0[0] + v0[1]) + (v0[2] + v0[3])) + ((v1[0] + v1[1]) + (v1[2] + v1[3]));
                    s2 += ((v0[0] * v0[0] + v0[1] * v0[1]) + (v0[2] * v0[2] + v0[3] * v0[3])) + ((v1[0] * v1[0] + v1[1] * v1[1]) + (v1[2] * v1[2] + v1[3] * v1[3]));
                    u32x4 w; w.x = cvt_pk_bf16(v0[0], v0[1]); w.y = cvt_pk_bf16(v0[2], v0[3]); w.z = cvt_pk_bf16(v1[0], v1[1]); w.w = cvt_pk_bf16(v1[2], v1[3]);
                    *(u32x4*)(rowp + bj * HALF) = w; }
                if (u.pn * BM >= stat_col0) {
                    s1 += __shfl_xor(s1, 16); s1 += __shfl_xor(s1, 32); s2 += __shfl_xor(s2, 16); s2 += __shfl_xor(s2, 32);
                    if (fq == 0) { float* sp = stats + (size_t)(row0 + ai * HALF + m * 16) * 32 + (((u.pn * BM - stat_col0) >> 8) * 4 + wc) * 2; sp[0] = s1; sp[1] = s2; } } }
    }
};
struct EpiSwiGLU {
    static constexpr bool PERM = true, AFTER_DRAIN = false;
    bf16_t* O; int ldc;
    __device__ __forceinline__ void operator()(const f32x4 (&acc)[2][2][4][2], const Unit& u, int wr, int wc, int fr, int fq) const {
        const int row0 = u.pm * BM + wr * 64 + fr; const int col0 = u.pn * HALF + wc * 32 + 8 * fq;
#pragma unroll
        for (int ai = 0; ai < 2; ++ai)
#pragma unroll
            for (int m = 0; m < 4; ++m) { bf16_t* rowp = O + (size_t)(row0 + ai * HALF + m * 16) * ldc + col0;
                f32x4 v0, v1;
#pragma unroll
                for (int i = 0; i < 4; ++i) { v0[i] = silu_f(acc[ai][0][m][0][i]) * acc[ai][1][m][0][i]; v1[i] = silu_f(acc[ai][0][m][1][i]) * acc[ai][1][m][1][i]; }
                u32x4 w; w.x = cvt_pk_bf16(v0[0], v0[1]); w.y = cvt_pk_bf16(v0[2], v0[3]); w.z = cvt_pk_bf16(v1[0], v1[1]); w.w = cvt_pk_bf16(v1[2], v1[3]);
                *(u32x4*)rowp = w; }
    }
};

template <class Epi, class Sched, bool ALIGN_EPI = false, bool SP2 = false>
__device__ __forceinline__ void gemm_phase(PG8_LAS unsigned char* lds, const Gemm g, const Sched& S, const Epi& E) {
    int tid_ = threadIdx.x; asm volatile("" : "+v"(tid_));
    const int tid = tid_, wid = __builtin_amdgcn_readfirstlane(tid >> 6), lane = tid & 63, wr = wid >> 2, wc = wid & 3, fr = lane & 15, fq = lane >> 4;
    const int K = g.K, nt = K / BK;
    unsigned voffA[2], voffB[2];
#pragma unroll
    for (int i = 0; i < 2; ++i) { int R, C; stage_rc(tid * 16 + i * 8192, R, C); const int Rb = Epi::PERM ? ((R & ~31) + perm32(R & 31)) : R;
        voffA[i] = (unsigned)(R * K + C) * 2u; voffB[i] = (unsigned)(Rb * K + C) * 2u; }
    const size_t kstep = (size_t)(BK * 2);
    const size_t hstep = (size_t)HALF * K * 2;
    const size_t tstep = 2 * hstep;
    const unsigned ldsw = (unsigned)wid * 1024u;
    const int aoff = lds_byte(wr * 64 + fr, fq * 8), boff = lds_byte(wc * 32 + fr, fq * 8);
#define PG8_SA(b, h) (((b) * 2 + (h)) * HTB)
#define PG8_SB(b, h) ((4 + (b) * 2 + (h)) * HTB)
#define PG8_STAGE(bufoff, gbase, voff) do { _Pragma("unroll") for (int _i = 0; _i < 2; ++_i) \
        __builtin_amdgcn_global_load_lds((const unsigned*)((const char*)(gbase) + (voff)[_i]), (PG8_LAS unsigned*)(lds + (bufoff) + ldsw + _i * 8192), 16, 0, 0); } while (0)
#define PG8_LDA(dst, b, h) do { _Pragma("unroll") for (int m = 0; m < 4; ++m) _Pragma("unroll") for (int k = 0; k < 2; ++k) dst[m][k] = *(const PG8_LAS bf16x8*)(lds + PG8_SA(b, h) + aoff + m * 2048 + k * 1024); } while (0)
#define PG8_LDB(dst, b, h) do { _Pragma("unroll") for (int n = 0; n < 2; ++n) _Pragma("unroll") for (int k = 0; k < 2; ++k) dst[n][k] = *(const PG8_LAS bf16x8*)(lds + PG8_SB(b, h) + boff + n * 2048 + k * 1024); } while (0)
#define PG8_MMA(ai, bj, At, Bt) do { __builtin_amdgcn_s_setprio(1); _Pragma("unroll") for (int m = 0; m < 4; ++m) _Pragma("unroll") for (int n = 0; n < 2; ++n) _Pragma("unroll") for (int k = 0; k < 2; ++k) \
        acc[ai][bj][m][n] = __builtin_amdgcn_mfma_f32_16x16x32_bf16(Bt[n][k], At[m][k], acc[ai][bj][m][n], 0, 0, 0); __builtin_amdgcn_s_setprio(0); } while (0)
#define PG8_WAIT_V(n) asm volatile("s_waitcnt vmcnt(" #n ")" ::: "memory")
#define PG8_WAIT_L(n) asm volatile("s_waitcnt lgkmcnt(" #n ")" ::: "memory")
#define PG8_BAR __builtin_amdgcn_s_barrier()
#define PG8_SCHED __builtin_amdgcn_sched_barrier(0)
    Unit cur, nxt; int ui = 0;
    if (!S.next(0, cur)) return;
    f32x4 acc[2][2][4][2];
#pragma unroll
    for (int a = 0; a < 2; ++a)
#pragma unroll
        for (int b = 0; b < 2; ++b)
#pragma unroll
            for (int m = 0; m < 4; ++m)
#pragma unroll
                for (int n = 0; n < 2; ++n) acc[a][b][m][n] = (f32x4){0.f, 0.f, 0.f, 0.f};
    bf16x8 At[4][2], B0[2][2], B1[2][2];
    const char* cA = (const char*)g.A + (size_t)cur.pm * tstep; const char* cB = (const char*)g.Bt + (size_t)cur.pn * tstep;
    S.a_ready(cur);
    if constexpr (SP2) {
        PG8_STAGE(PG8_SB(0, 0), cB, voffB); PG8_STAGE(PG8_SB(0, 1), cB + hstep, voffB); PG8_STAGE(PG8_SA(0, 0), cA, voffA); PG8_STAGE(PG8_SA(0, 1), cA + hstep, voffA);
        if (wr == 1) PG8_BAR;
        PG8_WAIT_V(2); PG8_BAR;
        PG8_STAGE(PG8_SB(1, 0), cB + kstep, voffB); PG8_STAGE(PG8_SA(1, 0), cA + kstep, voffA); PG8_STAGE(PG8_SB(1, 1), cB + hstep + kstep, voffB);
        PG8_WAIT_V(6); PG8_BAR;
    } else {
        PG8_STAGE(PG8_SB(0, 0), cB, voffB); PG8_STAGE(PG8_SA(0, 0), cA, voffA); PG8_STAGE(PG8_SB(0, 1), cB + hstep, voffB); PG8_STAGE(PG8_SA(0, 1), cA + hstep, voffA);
        if (wr == 1) PG8_BAR;
        PG8_WAIT_V(4); PG8_BAR;
        PG8_STAGE(PG8_SB(1, 0), cB + kstep, voffB); PG8_STAGE(PG8_SA(1, 0), cA + kstep, voffA); PG8_STAGE(PG8_SB(1, 1), cB + hstep + kstep, voffB);
        PG8_WAIT_V(6); PG8_BAR;
    }
    for (;;) {
        const bool has_next = S.next(ui + 1, nxt);
        const char* nA = has_next ? (const char*)g.A + (size_t)nxt.pm * tstep : cA; const char* nB = has_next ? (const char*)g.Bt + (size_t)nxt.pn * tstep : cB;
        for (int t = 0; t < nt; t += 2) {
            const bool last = (t == nt - 2);
            const char* a1 = cA + (size_t)(t + 1) * kstep;
            const char* a2 = last ? nA : cA + (size_t)(t + 2) * kstep; const char* b2 = last ? nB : cB + (size_t)(t + 2) * kstep;
            const char* a3 = a2 + kstep; const char* b3 = b2 + kstep;
            if (last && has_next) S.a_ready(nxt);
            if constexpr (SP2) {
            PG8_LDB(B0, 0, 0); PG8_LDB(B1, 0, 1); PG8_SCHED; PG8_LDA(At, 0, 0); PG8_STAGE(PG8_SA(1, 1), a1 + hstep, voffA);
            PG8_WAIT_V(8); PG8_WAIT_L(0); PG8_BAR; PG8_MMA(0, 0, At, B0); PG8_MMA(0, 1, At, B1); PG8_BAR; PG8_SCHED;
            PG8_LDA(At, 0, 1); PG8_STAGE(PG8_SB(0, 0), b2, voffB); PG8_STAGE(PG8_SB(0, 1), b2 + hstep, voffB); PG8_STAGE(PG8_SA(0, 0), a2, voffA);
            PG8_WAIT_V(8); PG8_WAIT_L(0); PG8_BAR; PG8_MMA(1, 0, At, B0); PG8_MMA(1, 1, At, B1); PG8_BAR; PG8_SCHED;
            PG8_LDB(B0, 1, 0); PG8_LDB(B1, 1, 1); PG8_SCHED; PG8_LDA(At, 1, 0); PG8_STAGE(PG8_SA(0, 1), a2 + hstep, voffA);
            PG8_WAIT_V(8); PG8_WAIT_L(0); PG8_BAR; PG8_MMA(0, 0, At, B0); PG8_MMA(0, 1, At, B1); PG8_BAR; PG8_SCHED;
            PG8_LDA(At, 1, 1); PG8_STAGE(PG8_SB(1, 0), b3, voffB); PG8_STAGE(PG8_SB(1, 1), b3 + hstep, voffB); PG8_STAGE(PG8_SA(1, 0), a3, voffA);
            PG8_WAIT_V(8); PG8_WAIT_L(0); PG8_BAR; PG8_MMA(1, 0, At, B0); PG8_MMA(1, 1, At, B1); PG8_BAR; PG8_SCHED;
            } else {
            PG8_LDB(B0, 0, 0); PG8_SCHED; PG8_LDA(At, 0, 0); PG8_STAGE(PG8_SA(1, 1), a1 + hstep, voffA);
            PG8_WAIT_L(8); PG8_BAR; PG8_WAIT_L(0); PG8_MMA(0, 0, At, B0); PG8_BAR; PG8_SCHED;
            PG8_LDB(B1, 0, 1); PG8_STAGE(PG8_SB(0, 0), b2, voffB);
            PG8_BAR; PG8_WAIT_L(0); PG8_MMA(0, 1, At, B1); PG8_BAR;
            PG8_LDA(At, 0, 1); PG8_STAGE(PG8_SA(0, 0), a2, voffA);
            PG8_BAR; PG8_WAIT_L(0); PG8_MMA(1, 0, At, B0); PG8_BAR; PG8_SCHED;
            PG8_STAGE(PG8_SB(0, 1), b2 + hstep, voffB);
            PG8_WAIT_V(6); PG8_BAR; PG8_MMA(1, 1, At, B1); PG8_BAR;
            PG8_LDB(B0, 1, 0); PG8_SCHED; PG8_LDA(At, 1, 0); PG8_STAGE(PG8_SA(0, 1), a2 + hstep, voffA);
            PG8_WAIT_L(8); PG8_BAR; PG8_WAIT_L(0); PG8_MMA(0, 0, At, B0); PG8_BAR; PG8_SCHED;
            PG8_LDB(B1, 1, 1); PG8_STAGE(PG8_SB(1, 0), b3, voffB);
            PG8_BAR; PG8_WAIT_L(0); PG8_MMA(0, 1, At, B1); PG8_BAR;
            PG8_LDA(At, 1, 1); PG8_STAGE(PG8_SA(1, 0), a3, voffA);
            PG8_BAR; PG8_WAIT_L(0); PG8_MMA(1, 0, At, B0); PG8_BAR; PG8_SCHED;
            PG8_STAGE(PG8_SB(1, 1), b3 + hstep, voffB);
            PG8_WAIT_V(6); PG8_BAR; PG8_MMA(1, 1, At, B1); PG8_BAR;
            }
        }
        if constexpr (ALIGN_EPI) { if (wr == 0) PG8_BAR; }
        if constexpr (!Epi::AFTER_DRAIN) { E(acc, cur, wr, wc, fr, fq); S.done(cur); }
        if (!has_next) break;
#pragma unroll
        for (int a = 0; a < 2; ++a)
#pragma unroll
            for (int b = 0; b < 2; ++b)
#pragma unroll
                for (int m = 0; m < 4; ++m)
#pragma unroll
                    for (int n = 0; n < 2; ++n) acc[a][b][m][n] = (f32x4){0.f, 0.f, 0.f, 0.f};
        cur = nxt; cA = nA; cB = nB; ++ui;
        if constexpr (ALIGN_EPI) { if (wr == 1) PG8_BAR; }
    }
    PG8_WAIT_V(0);
    if constexpr (!ALIGN_EPI) { if (wr == 0) PG8_BAR; }
    PG8_BAR;
    if constexpr (Epi::AFTER_DRAIN) { E.fused(acc, cur, wr, wc, fr, fq, lds, wid, lane); S.done(cur); }
#undef PG8_SA
#undef PG8_SB
#undef PG8_STAGE
#undef PG8_LDA
#undef PG8_LDB
#undef PG8_MMA
#undef PG8_WAIT_V
#undef PG8_WAIT_L
#undef PG8_BAR
#undef PG8_SCHED
}

}

typedef unsigned short bf16_t;
typedef float f32x4 __attribute__((ext_vector_type(4)));
typedef unsigned u32x4 __attribute__((ext_vector_type(4)));
typedef unsigned u32x2 __attribute__((ext_vector_type(2)));
typedef short bf16x8 __attribute__((ext_vector_type(8)));

constexpr int D = 1024, NTOK = 98304, NPT = 65536, NSEQ = 36, FFH = 2816;
constexpr float EPS = 1e-6f;
constexpr int LDS_BYTES = 135168;
constexpr size_t WS_BAR  = 0;
constexpr size_t WS_MOD  = 16384;
constexpr size_t WS_W1   = WS_MOD  + (size_t)NSEQ * 4 * 6144 * 4;
constexpr size_t WS_W2   = WS_W1   + (size_t)3328 * 1024 * 2;
constexpr size_t WS_W3   = WS_W2   + (size_t)1024 * 1024 * 2;
constexpr size_t WS_W4   = WS_W3   + (size_t)5632 * 1024 * 2;
constexpr size_t WS_WS   = WS_W4   + (size_t)1024 * 2816 * 2;
constexpr size_t WS_WSUM = WS_WS   + (size_t)4 * 128 * 128 * 2;
constexpr size_t WS_GATE = WS_WSUM + 4096;
constexpr size_t WS_A    = WS_GATE + (size_t)NTOK * 32 * 4;
constexpr size_t WS_O2   = WS_A    + (size_t)NTOK * 1024 * 2;
constexpr size_t WS_B    = WS_O2   + (size_t)NTOK * 1024 * 2;
constexpr size_t WS_END  = WS_B    + (size_t)NTOK * 3072 * 2;

struct Params { const float* in[22]; float* out; unsigned char* ws; };

__device__ __forceinline__ float wave_sum(float v) {
#pragma unroll
    for (int o = 1; o < 64; o <<= 1) v += __shfl_xor(v, o);
    return v;
}
__device__ __forceinline__ float bf2f(bf16_t b) { return __uint_as_float(((unsigned)b) << 16); }
typedef float f32x2_t __attribute__((ext_vector_type(2)));
typedef __bf16 bf16x2_t __attribute__((ext_vector_type(2)));
__device__ __forceinline__ unsigned pk2(float lo, float hi) { const f32x2_t v = {lo, hi}; return __builtin_bit_cast(unsigned, __builtin_convertvector(v, bf16x2_t)); }
__device__ __forceinline__ bf16_t f2bf(float f) { return (bf16_t)(pk2(f, 0.f) & 0xffffu); }
__device__ __forceinline__ f32x4 unpack4(u32x2 w) { f32x4 r; r[0] = __uint_as_float(w.x << 16); r[1] = __uint_as_float(w.x & 0xffff0000u); r[2] = __uint_as_float(w.y << 16); r[3] = __uint_as_float(w.y & 0xffff0000u); return r; }
__device__ __forceinline__ int seq_of(int tok) { return tok < NPT ? (tok >> 11) : 32 + ((tok - NPT) >> 13); }
#define LDS_WAIT() asm volatile("s_waitcnt lgkmcnt(0)" ::: "memory")
__device__ __forceinline__ int opaque_tid() { int t = threadIdx.x; asm volatile("" : "+v"(t)); return t; }

#define LAS __attribute__((address_space(3)))
#define XB_TMO      128
#define XB_XCNT(j)  (256  + 64 * (j))
#define XB_XSUB(j)  (1280 + 64 * (j))
#define XB_XGEN(j)  (2304 + 64 * (j))
#define XB_TOP      3328
#define XB_TOPGEN   3392
#define XCD_BAR_WORDS 3456
#define XB_SPIN_CAP (1u << 23)

__device__ __forceinline__ unsigned xb_ld(unsigned* p)              { return __hip_atomic_load(p, __ATOMIC_RELAXED, __HIP_MEMORY_SCOPE_AGENT); }
__device__ __forceinline__ unsigned xb_add(unsigned* p, unsigned v) { return __hip_atomic_fetch_add(p, v, __ATOMIC_RELAXED, __HIP_MEMORY_SCOPE_AGENT); }
__device__ __forceinline__ unsigned xb_xcc_id() { return (unsigned)__builtin_amdgcn_s_getreg((3 << 11) | 20) & 0xFu; }
#define XB_SPIN(cond, bar) do { unsigned _sp = 0; while (cond) { __builtin_amdgcn_s_sleep(1); \
    if ((++_sp & 255u) == 0u) { if (xb_ld(&(bar)[XB_TMO])) break; if (_sp > XB_SPIN_CAP) { atomicAdd(&(bar)[XB_TMO], 1u); break; } } } } while (0)

struct XcdBarrier {
    unsigned* bar; unsigned x;
    volatile LAS unsigned* st;
};

__device__ __forceinline__ XcdBarrier xcd_barrier_post(unsigned* bar, volatile LAS unsigned* st) {
    XcdBarrier b; b.bar = bar; b.x = xb_xcc_id(); b.st = st;
    if (threadIdx.x == 0) (void)xb_add(&bar[XB_XCNT(b.x)], 1u);
    return b;
}
__device__ __forceinline__ void xcd_barrier_complete(unsigned* bar, unsigned x, unsigned& nloc, unsigned& nx) {
    const unsigned G = gridDim.x * gridDim.y * gridDim.z;
    unsigned sum, cnt, mine, sp = 0u;
    for (;;) {
        sum = 0u; cnt = 0u; mine = 0u;
#pragma unroll
        for (unsigned j = 0; j < 16; ++j) { const unsigned c = xb_ld(&bar[XB_XCNT(j)]); sum += c; cnt += (c > 0u) ? 1u : 0u; mine = (j == x) ? c : mine; }
        if (sum == G) break;
        __builtin_amdgcn_s_sleep(1);
        if ((++sp & 255u) == 0u) { if (xb_ld(&bar[XB_TMO])) break; if (sp > XB_SPIN_CAP) { atomicAdd(&bar[XB_TMO], 1u); break; } }
    }
    nloc = mine > 0u ? mine : 1u; nx = cnt > 0u ? cnt : 1u;
}

__device__ __forceinline__ void xcd_barrier(const XcdBarrier& b) {
    asm volatile("s_waitcnt vmcnt(0)" ::: "memory");
    __syncthreads();
    if (threadIdx.x == 0) {
        unsigned* bar = b.bar;
        __builtin_amdgcn_s_waitcnt(0);
        unsigned nloc = b.st[0], nx = b.st[1];
        if (nloc == 0u) { xcd_barrier_complete(bar, b.x, nloc, nx); b.st[0] = nloc; b.st[1] = nx; }
        const unsigned old = xb_add(&bar[XB_XSUB(b.x)], 1u);
        const unsigned gen = old / nloc;
        if (old + 1u == (gen + 1u) * nloc) {
            __builtin_amdgcn_fence(__ATOMIC_RELEASE, "agent");
            asm volatile("s_waitcnt vmcnt(0)" ::: "memory");
            const unsigned og = xb_add(&bar[XB_TOP], 1u);
            const unsigned tg = og / nx;
            if (og + 1u == (tg + 1u) * nx) xb_add(&bar[XB_TOPGEN], 1u);
            else XB_SPIN(xb_ld(&bar[XB_TOPGEN]) == tg, bar);
            __builtin_amdgcn_fence(__ATOMIC_ACQUIRE, "agent");
            xb_add(&bar[XB_XGEN(b.x)], 1u);
            asm volatile("s_waitcnt vmcnt(0)" ::: "memory");
        } else {
            XB_SPIN(xb_ld(&bar[XB_XGEN(b.x)]) == gen, bar);
            __builtin_amdgcn_fence(__ATOMIC_ACQUIRE, "agent");
            asm volatile("s_waitcnt vmcnt(0)" ::: "memory");
        }
    }
    __syncthreads();
}


__device__ __forceinline__ void phase_mod(const Params& p, unsigned char* lds) {
    float* scs = (float*)lds;
    float* red = (float*)(lds + 36864);
    const float* c_prompt = p.in[2]; const float* c_sample = p.in[3]; const float* w_ada = p.in[5]; const float* b_ada = p.in[6];
    float* mod = (float*)(p.ws + WS_MOD);
    const int tid = opaque_tid(), col = tid % 96, kq = tid / 96;
    for (int item = blockIdx.x; item < 256; item += gridDim.x) {
        const int l = item >> 6, col0 = (item & 63) * 96;
        float acc[36];
#pragma unroll
        for (int s = 0; s < 36; ++s) acc[s] = 0.f;
        for (int k0 = 0; k0 < 1024; k0 += 256) {
            __syncthreads();
            for (int e = tid; e < 36 * 256; e += 512) { const int s = e >> 8, kk = e & 255;
                const float c = s < 32 ? c_prompt[s * 1024 + k0 + kk] : c_sample[(s - 32) * 1024 + k0 + kk];
                scs[kk * 36 + s] = c / (1.0f + __expf(-c)); }
            __syncthreads();
            if (tid < 384) {
                const float* wp = w_ada + ((size_t)l * 1024 + k0 + kq * 64) * 6144 + col0 + col;
                for (int kb = 0; kb < 64; kb += 16) {
                    float w[16];
#pragma unroll
                    for (int u = 0; u < 16; ++u) w[u] = __builtin_nontemporal_load(wp + (size_t)(kb + u) * 6144);
#pragma unroll
                    for (int u = 0; u < 16; ++u) { const f32x4* sp = (const f32x4*)(scs + (kq * 64 + kb + u) * 36);
#pragma unroll
                        for (int s4 = 0; s4 < 9; ++s4) { const f32x4 sv = sp[s4];
                            acc[4 * s4 + 0] += sv[0] * w[u]; acc[4 * s4 + 1] += sv[1] * w[u]; acc[4 * s4 + 2] += sv[2] * w[u]; acc[4 * s4 + 3] += sv[3] * w[u]; } }
                }
            }
        }
        __syncthreads();
        if (tid < 384) {
#pragma unroll
            for (int s = 0; s < 36; ++s) red[(kq * 96 + col) * 36 + s] = acc[s];
        }
        __syncthreads();
        for (int e = tid; e < 96 * 36; e += 512) { const int cc = e % 96, s = e / 96;
            const float v = red[(0 * 96 + cc) * 36 + s] + red[(1 * 96 + cc) * 36 + s] + red[(2 * 96 + cc) * 36 + s] + red[(3 * 96 + cc) * 36 + s] + b_ada[l * 6144 + col0 + cc];
            mod[((size_t)s * 4 + l) * 6144 + col0 + cc] = v; }
    }
    __syncthreads();
}

struct RowId  { __device__ __forceinline__ int operator()(int n) const { return n; } };
struct RowFfn { __device__ __forceinline__ int operator()(int n) const { const int b = n >= FFH ? 1 : 0; const int j = n - b * FFH; return (j >> 7) * 256 + b * 128 + (j & 127); } };
template <class RM>
__device__ __forceinline__ void transpose_item(const float* W, int K, int N, bf16_t* WT, RM rm, float* scr, int item, int lane) {
    const int nblk = N >> 5, kb = item / nblk, nb = item - kb * nblk, k0 = 64 * kb, n0 = 32 * nb;
#pragma unroll 8
    for (int i = 0; i < 32; ++i) { const int kk = 2 * i + (lane >> 5); scr[kk * 33 + (lane & 31)] = W[(size_t)(k0 + kk) * N + n0 + (lane & 31)]; }
    LDS_WAIT();
    const int c = lane & 7;
#pragma unroll
    for (int j = 0; j < 4; ++j) { const int n = (lane >> 3) + 8 * j; const float* s = scr + (8 * c) * 33 + n;
        u32x4 o; o.x = pk2(s[0 * 33], s[1 * 33]); o.y = pk2(s[2 * 33], s[3 * 33]); o.z = pk2(s[4 * 33], s[5 * 33]); o.w = pk2(s[6 * 33], s[7 * 33]);
        *(u32x4*)(WT + (size_t)rm(n0 + n) * K + k0 + 8 * c) = o; }
    LDS_WAIT();
}
__device__ __forceinline__ void phase_convert(const Params& p, int l, unsigned char* lds) {
    const int tid = opaque_tid(), lane = tid & 63, wave = __builtin_amdgcn_readfirstlane(tid >> 6), j = l >> 1; const int gw = blockIdx.x * 8 + wave, NGW = gridDim.x * 8; const bool gla = (l & 1) == 0;
    float* scr = (float*)(lds + wave * 8448);
    bf16_t* W1 = (bf16_t*)(p.ws + WS_W1); bf16_t* W2 = (bf16_t*)(p.ws + WS_W2); bf16_t* W3 = (bf16_t*)(p.ws + WS_W3); bf16_t* W4 = (bf16_t*)(p.ws + WS_W4);
    const int n1 = gla ? 3072 : 2048;
    const float *wi0 = p.in[7], *wi1 = p.in[13], *wo0 = p.in[12], *wo1 = p.in[19];
    asm volatile("" : "+s"(wi0), "+s"(wi1), "+s"(wo0), "+s"(wo1));
    const float* win = gla ? wi0 + (size_t)j * 1024 * 3072 : wi1 + (size_t)j * 1024 * 2048;
    const float* wout = (gla ? wo0 : wo1) + (size_t)j * 1024 * 1024;
    const float* fin = p.in[20] + (size_t)l * 1024 * 5632; const float* fout = p.in[21] + (size_t)l * FFH * 1024;
    const int I1 = 16 * (n1 / 32), I2 = 16 * 32, I3 = 16 * 176, I4 = 44 * 32, NI = I1 + I2 + I3 + I4;
    for (int it = gw; it < NI; it += NGW) {
        int r = it;
        if (r < I1) { transpose_item(win, 1024, n1, W1, RowId(), scr, r, lane); continue; } r -= I1;
        if (r < I2) { transpose_item(wout, 1024, 1024, W2, RowId(), scr, r, lane); continue; } r -= I2;
        if (r < I3) { transpose_item(fin, 1024, 5632, W3, RowFfn(), scr, r, lane); continue; } r -= I3;
        transpose_item(fout, FFH, 1024, W4, RowId(), scr, r, lane);
    }
    const int gt = gw * 64 + lane, NGT = NGW * 64;
    if (gla) {
        const float* gk1 = p.in[8] + (size_t)j * 2 * 1024 * 16;
        for (int e = gt; e < 32 * 1024; e += NGT) { const int row = e >> 10, k = e & 1023, ee = row >> 4, r = row & 15;
            W1[(size_t)(3072 + row) * 1024 + k] = f2bf(gk1[((size_t)ee * 1024 + k) * 16 + r]); }
    } else {
        const float* wsrc = p.in[17] + (size_t)j * 4 * 128 * 128; bf16_t* WS = (bf16_t*)(p.ws + WS_WS);
        for (int e = gt; e < 4 * 128 * 128; e += NGT) WS[e] = f2bf(wsrc[e]);
        float* wsum = (float*)(p.ws + WS_WSUM);
        for (int e = gt; e < 4 * 128; e += NGT) { float a = 0.f; for (int s2 = 0; s2 < 128; ++s2) a += bf2f(f2bf(wsrc[(size_t)e * 128 + s2])); wsum[e] = a; }
    }
}

struct V8 { f32x4 lo, hi; };
__device__ __forceinline__ V8 unpack8(u32x4 w) { V8 r; r.lo = unpack4((u32x2){w.x, w.y}); r.hi = unpack4((u32x2){w.z, w.w}); return r; }
__device__ __forceinline__ u32x4 pack8(f32x4 lo, f32x4 hi) { return (u32x4){pk2(lo[0], lo[1]), pk2(lo[2], lo[3]), pk2(hi[0], hi[1]), pk2(hi[2], hi[3])}; }
__device__ __forceinline__ float sumsq4(f32x4 v) { return (v[0] * v[0] + v[1] * v[1]) + (v[2] * v[2] + v[3] * v[3]); }
template <int x_mode_in>
__device__ __forceinline__ void phase_elem(const Params& p, bool has_y, int l_res, int jg, int ngi_res, int x_mode_out, bool write_h, int l_h, int jsh, int ngi_h) {
    const int tid = opaque_tid(), lane = tid & 63, gw = blockIdx.x * 8 + __builtin_amdgcn_readfirstlane(tid >> 6), NGW = gridDim.x * 8;
    const float* mod = (const float*)(p.ws + WS_MOD); const float* norm_g = p.in[4];
    const bf16_t* Y = (const bf16_t*)(p.ws + WS_O2); bf16_t* H = (bf16_t*)(p.ws + WS_A); bf16_t* XB = (bf16_t*)p.out;
    for (int b = gw; b < NTOK / 16; b += NGW) {
        const int pos = b >> 4, pmo = 48 * ((pos & 63) >> 3) + 8 * (pos >> 6) + (pos & 7);
        const int tok0 = pmo * 256 + (b & 15) * 16, s = seq_of(tok0);
        f32x4 ar[2][2], ah[2][2], sh[2][2];
#pragma unroll
        for (int j = 0; j < 2; ++j)
#pragma unroll
            for (int k = 0; k < 2; ++k) { ar[j][k] = (f32x4){0.f, 0.f, 0.f, 0.f}; ah[j][k] = ar[j][k]; sh[j][k] = ar[j][k]; }
        if (has_y) { const float* gp = mod + (((size_t)s * 4 + l_res) * 6 + jg) * 1024 + 8 * lane; const float* np = norm_g + (l_res * 4 + ngi_res) * 1024 + 8 * lane;
#pragma unroll
            for (int j = 0; j < 2; ++j)
#pragma unroll
                for (int k = 0; k < 2; ++k) ar[j][k] = *(const f32x4*)(gp + 512 * j + 4 * k) * *(const f32x4*)(np + 512 * j + 4 * k); }
        if (write_h) { const float* shp = mod + (((size_t)s * 4 + l_h) * 6 + jsh) * 1024 + 8 * lane; const float* scp = shp + 1024; const float* np = norm_g + (l_h * 4 + ngi_h) * 1024 + 8 * lane;
#pragma unroll
            for (int j = 0; j < 2; ++j)
#pragma unroll
                for (int k = 0; k < 2; ++k) { ah[j][k] = *(const f32x4*)(np + 512 * j + 4 * k) * (*(const f32x4*)(scp + 512 * j + 4 * k) + 1.0f); sh[j][k] = *(const f32x4*)(shp + 512 * j + 4 * k); } }
        f32x4 xr[2][2][2][2]; u32x4 xb[2][2][2], yb[2][2][2];
#define ELEM_LOAD(buf, tk) do { _Pragma("unroll") for (int q_ = 0; q_ < 2; ++q_) { const int tk_ = (tk) + q_; \
            if (x_mode_in == 0) { const float* xs_ = (tk_ < NPT ? p.in[0] + (size_t)tk_ * 1024 : p.in[1] + (size_t)(tk_ - NPT) * 1024) + 8 * lane; \
                _Pragma("unroll") for (int j = 0; j < 2; ++j) { xr[buf][q_][j][0] = *(const f32x4*)(xs_ + 512 * j); xr[buf][q_][j][1] = *(const f32x4*)(xs_ + 512 * j + 4); } } \
            else { _Pragma("unroll") for (int j = 0; j < 2; ++j) xb[buf][q_][j] = *(const u32x4*)(XB + (size_t)tk_ * 2048 + 512 * j + 8 * lane); } \
            if (has_y) { _Pragma("unroll") for (int j = 0; j < 2; ++j) yb[buf][q_][j] = *(const u32x4*)(Y + (size_t)tk_ * 1024 + 512 * j + 8 * lane); } } } while (0)
#define ELEM_BODY(buf, q_, tok_) do { const int tok = (tok_); \
            f32x4 x[2][2], y[2][2]; \
            _Pragma("unroll") for (int j = 0; j < 2; ++j) { \
                if (x_mode_in == 0) { x[j][0] = xr[buf][q_][j][0]; x[j][1] = xr[buf][q_][j][1]; } else { const V8 t_ = unpack8(xb[buf][q_][j]); x[j][0] = t_.lo; x[j][1] = t_.hi; } \
                if (has_y) { const V8 t_ = unpack8(yb[buf][q_][j]); y[j][0] = t_.lo; y[j][1] = t_.hi; } else { y[j][0] = (f32x4){0.f, 0.f, 0.f, 0.f}; y[j][1] = y[j][0]; } } \
            if (has_y) { const float ss = (sumsq4(y[0][0]) + sumsq4(y[0][1])) + (sumsq4(y[1][0]) + sumsq4(y[1][1])); \
                const float r = rsqrtf(wave_sum(ss) * (1.0f / 1024.0f) + EPS); \
                _Pragma("unroll") for (int j = 0; j < 2; ++j) _Pragma("unroll") for (int k = 0; k < 2; ++k) x[j][k] += ar[j][k] * (y[j][k] * r); } \
            if (x_mode_out == 2) { _Pragma("unroll") for (int j = 0; j < 2; ++j) _Pragma("unroll") for (int k = 0; k < 2; ++k) *(f32x4*)(p.out + (size_t)tok * 1024 + 512 * j + 8 * lane + 4 * k) = x[j][k]; } \
            else if (x_mode_out == 1) { _Pragma("unroll") for (int j = 0; j < 2; ++j) { const u32x4 w = pack8(x[j][0], x[j][1]); *(u32x4*)(XB + (size_t)tok * 2048 + 512 * j + 8 * lane) = w; \
                    const V8 t_ = unpack8(w); x[j][0] = t_.lo; x[j][1] = t_.hi; } } \
            if (write_h) { const float ss = (sumsq4(x[0][0]) + sumsq4(x[0][1])) + (sumsq4(x[1][0]) + sumsq4(x[1][1])); \
                const float r = rsqrtf(wave_sum(ss) * (1.0f / 1024.0f) + EPS); \
                _Pragma("unroll") for (int j = 0; j < 2; ++j) { const f32x4 h0 = (x[j][0] * r) * ah[j][0] + sh[j][0], h1 = (x[j][1] * r) * ah[j][1] + sh[j][1]; \
                    *(u32x4*)(H + (size_t)tok * 1024 + 512 * j + 8 * lane) = pack8(h0, h1); } } } while (0)
        ELEM_LOAD(0, tok0);
#pragma unroll 1
        for (int t = 0; t < 16; t += 4) {
            ELEM_LOAD(1, tok0 + t + 2);
            ELEM_BODY(0, 0, tok0 + t); ELEM_BODY(0, 1, tok0 + t + 1);
            if (t + 4 < 16) ELEM_LOAD(0, tok0 + t + 4);
            ELEM_BODY(1, 0, tok0 + t + 2); ELEM_BODY(1, 1, tok0 + t + 3);
        }
#undef ELEM_BODY
#undef ELEM_LOAD
    }
}

__device__ __forceinline__ void phase_gla_combine(const Params& p, int jl) {
    const int tid = opaque_tid(), lane = tid & 63, gw = blockIdx.x * 8 + __builtin_amdgcn_readfirstlane(tid >> 6), NGW = gridDim.x * 8;
    bf16_t* OF = (bf16_t*)(p.ws + WS_A); const bf16_t* OB = (const bf16_t*)(p.ws + WS_O2); const bf16_t* PR = (const bf16_t*)(p.ws + WS_B);
    const float* ghp = p.in[11] + jl * 256 + 8 * (lane & 31); const f32x4 gh0 = *(const f32x4*)ghp, gh1 = *(const f32x4*)(ghp + 4);
    for (int tok = gw; tok < NTOK; tok += NGW) {
        u32x4 a[2], bq[2], rq[2], c[2], d[2];
#pragma unroll
        for (int j = 0; j < 2; ++j) { const size_t off = (size_t)tok * 1024 + 512 * j + 8 * lane;
            a[j] = *(const u32x4*)(OF + off); bq[j] = *(const u32x4*)(OB + off); rq[j] = *(const u32x4*)(PR + (size_t)tok * 3072 + 2048 + 512 * j + 8 * lane);
            if (tok >= NPT) { const bf16_t* XS = (const bf16_t*)p.out + 1024 + 512 * j + 8 * lane;
                c[j] = *(const u32x4*)(XS + (size_t)tok * 2048); d[j] = *(const u32x4*)(XS + (size_t)(tok - NPT) * 2048); } }
#pragma unroll
        for (int j = 0; j < 2; ++j) { const size_t off = (size_t)tok * 1024 + 512 * j + 8 * lane;
            const V8 va = unpack8(a[j]), vb = unpack8(bq[j]), vr = unpack8(rq[j]); f32x4 o0 = va.lo + vb.lo, o1 = va.hi + vb.hi;
            if (tok >= NPT) { const V8 vc = unpack8(c[j]), vd = unpack8(d[j]); o0 += vc.lo + vd.lo; o1 += vc.hi + vd.hi; }
            float ss = sumsq4(o0) + sumsq4(o1);
#pragma unroll
            for (int m = 1; m < 32; m <<= 1) ss += __shfl_xor(ss, m);
            const float r = rsqrtf(ss * (1.0f / 256.0f) + EPS);
            f32x4 m0, m1;
#pragma unroll
            for (int i = 0; i < 4; ++i) { m0[i] = o0[i] * r * gh0[i] * pg8::silu_f(vr.lo[i]); m1[i] = o1[i] * r * gh1[i] * pg8::silu_f(vr.hi[i]); }
            *(u32x4*)(OF + off) = pack8(m0, m1); }
    }
}

__device__ __forceinline__ void phase_sgu_mfma(const Params& p, int jl, unsigned char* lds) {
    const bf16_t* Z = (const bf16_t*)(p.ws + WS_B); bf16_t* MO = (bf16_t*)(p.ws + WS_A); const bf16_t* WSB = (const bf16_t*)(p.ws + WS_WS);
    const float* ln_g = p.in[15] + jl * 1024; const float* ln_b = p.in[16] + jl * 1024; const float* b_s = p.in[18] + jl * 4 * 128; const float* wsum = (const float*)(p.ws + WS_WSUM); const float* SP = (const float*)(p.ws + WS_GATE);
    float* stats = (float*)lds;
    unsigned char* wsm = lds + 1024;
    unsigned char* vT = lds + 1024 + 128 * 272;
    const int tid = opaque_tid(), lane = tid & 63, wave = __builtin_amdgcn_readfirstlane(tid >> 6), fr = lane & 15, fq = lane >> 4;
    for (int chunk = blockIdx.x; chunk < NTOK / 128; chunk += gridDim.x) {
        const int tok0 = chunk * 128;
        if (tid < 128) { const f32x4* sp = (const f32x4*)(SP + (size_t)(tok0 + tid) * 32); float s1 = 0.f, s2 = 0.f;
#pragma unroll
            for (int i = 0; i < 8; ++i) { const f32x4 v = sp[i]; s1 += v[0] + v[2]; s2 += v[1] + v[3]; }
            const float mean = s1 * (1.0f / 1024.0f), var = fmaxf(s2 * (1.0f / 1024.0f) - mean * mean, 0.f);
            stats[tid * 2] = mean; stats[tid * 2 + 1] = rsqrtf(var + EPS); }
        __syncthreads();
        const int srow = lane + 64 * (wave & 1);
        const float mean = stats[srow * 2], rstd = stats[srow * 2 + 1];
        for (int g = 0; g < 4; ++g) {
#pragma unroll
            for (int i = 0; i < 4; ++i) { const int e = tid + 512 * i, t = e >> 4, c16 = e & 15;
                *(u32x4*)(wsm + t * 272 + c16 * 16) = *(const u32x4*)(WSB + (size_t)(g * 128 + t) * 128 + c16 * 8); }
            { u32x4 raw[8];
#pragma unroll
              for (int i = 0; i < 8; ++i) raw[i] = *(const u32x4*)(Z + (size_t)(tok0 + srow) * 2048 + 1024 + g * 256 + ((wave >> 1) + 4 * i) * 8);
#pragma unroll
              for (int i = 0; i < 8; ++i) { const int dblk = (wave >> 1) + 4 * i;
                const f32x4 x0 = unpack4((u32x2){raw[i].x, raw[i].y}), x1 = unpack4((u32x2){raw[i].z, raw[i].w});
                const f32x4 y0 = (x0 - mean) * rstd, y1 = (x1 - mean) * rstd;
                const unsigned p0 = pk2(y0[0], y0[1]), p1 = pk2(y0[2], y0[3]), p2 = pk2(y1[0], y1[1]), p3 = pk2(y1[2], y1[3]);
                bf16_t* dst = (bf16_t*)(vT + (dblk * 8) * 272 + srow * 2);
                dst[0 * 136] = (bf16_t)(p0 & 0xffffu); dst[1 * 136] = (bf16_t)(p0 >> 16); dst[2 * 136] = (bf16_t)(p1 & 0xffffu); dst[3 * 136] = (bf16_t)(p1 >> 16);
                dst[4 * 136] = (bf16_t)(p2 & 0xffffu); dst[5 * 136] = (bf16_t)(p2 >> 16); dst[6 * 136] = (bf16_t)(p3 & 0xffffu); dst[7 * 136] = (bf16_t)(p3 >> 16); } }
            __syncthreads();
            f32x4 acc[2][8];
#pragma unroll
            for (int dt = 0; dt < 2; ++dt)
#pragma unroll
                for (int tt = 0; tt < 8; ++tt) acc[dt][tt] = (f32x4){0.f, 0.f, 0.f, 0.f};
#pragma unroll
            for (int ks = 0; ks < 4; ++ks) {
                bf16x8 af[2];
#pragma unroll
                for (int dt = 0; dt < 2; ++dt) af[dt] = *(const bf16x8*)(vT + (wave * 32 + 8 * (fr >> 2) + 4 * dt + (fr & 3)) * 272 + (ks * 32 + fq * 8) * 2);
#pragma unroll
                for (int tt = 0; tt < 8; ++tt) { const bf16x8 bf = *(const bf16x8*)(wsm + (tt * 16 + fr) * 272 + (ks * 32 + fq * 8) * 2);
#pragma unroll
                    for (int dt = 0; dt < 2; ++dt) acc[dt][tt] = __builtin_amdgcn_mfma_f32_16x16x32_bf16(af[dt], bf, acc[dt][tt], 0, 0, 0); }
            }
            { const int col = g * 256 + wave * 32 + 8 * fq;
              f32x4 lg[2], lb[2];
#pragma unroll
              for (int dt = 0; dt < 2; ++dt) { lg[dt] = *(const f32x4*)(ln_g + col + 4 * dt); lb[dt] = *(const f32x4*)(ln_b + col + 4 * dt); }
              u32x4 uraw[8];
#pragma unroll
              for (int tt = 0; tt < 8; ++tt) uraw[tt] = *(const u32x4*)(Z + (size_t)(tok0 + tt * 16 + fr) * 2048 + col);
#pragma unroll
              for (int tt = 0; tt < 8; ++tt) { const int t = tt * 16 + fr; const float bs = b_s[g * 128 + t], wsm_t = wsum[g * 128 + t];
                const f32x4 u0 = unpack4((u32x2){uraw[tt].x, uraw[tt].y}), u1 = unpack4((u32x2){uraw[tt].z, uraw[tt].w});
                const f32x4 o0 = (acc[0][tt] * lg[0] + (lb[0] * wsm_t + bs)) * u0, o1 = (acc[1][tt] * lg[1] + (lb[1] * wsm_t + bs)) * u1;
                *(u32x4*)(MO + (size_t)(tok0 + t) * 1024 + col) = (u32x4){pk2(o0[0], o0[1]), pk2(o0[2], o0[3]), pk2(o1[0], o1[1]), pk2(o1[2], o1[3])}; } }
            __syncthreads();
        }
    }
}

#define LDS_BARRIER() do { asm volatile("s_waitcnt lgkmcnt(0)" ::: "memory"); __builtin_amdgcn_s_barrier(); asm volatile("" ::: "memory"); } while (0)
typedef float f32x2 __attribute__((ext_vector_type(2)));
__device__ __forceinline__ f32x2 ex2v(f32x2 x) { f32x2 r; r.x = __builtin_amdgcn_exp2f(x.x); r.y = __builtin_amdgcn_exp2f(x.y); return r; }
template <int DKH, int DVW>
__device__ __forceinline__ void gla_chain(const Params& p, int jl, unsigned char* lds, int seq, int h, int e, int dk0, int dv0, bf16_t* OUTB, int ostride, int orow_off) {
    constexpr int PAIRS = DKH / 2, NSEG = 512 / PAIRS, NP = 64 / NSEG, KS = DKH / 32, DKT = DKH / 16, DT = DVW / 16, NV = DVW / 8;
    const bf16_t* PR = (const bf16_t*)(p.ws + WS_B); const float* G1 = (const float*)(p.ws + WS_GATE);
    const float* w2 = p.in[9] + (size_t)jl * 2 * 16 * 512; const float* bgk = p.in[10] + (size_t)jl * 2 * 512;
    const int tid = opaque_tid(), lane = tid & 63, wave = __builtin_amdgcn_readfirstlane(tid >> 6), fr = lane & 15, fq = lane >> 4;
    const int dkp = lane & (PAIRS - 1), seg = DKH == 128 ? wave : wave * 2 + (lane >> 5);
    float* g1s = (float*)lds; float* segtot = (float*)(lds + 8192); float* decs = (float*)(lds + 12288);
    float* w2s = (float*)(lds + 112640);
    unsigned char* qd = lds + 13312; unsigned char* kd = lds + 30720; unsigned char* keT = lds + 48128; unsigned char* sc = lds + 66560; unsigned char* vTw = lds + 75776 + wave * 4608;
    const float LOG2E = 1.4426950408889634f, QSCALE = 0.08838834764831845f;
    const int gc = tid >> 2, gr4 = tid & 3;
    {
        const int L = seq < 32 ? 2048 : 8192, t0 = seq < 32 ? seq * 2048 : NPT + (seq - 32) * 8192, nch = L >> 6;
        f32x4 Sacc[DKT][DT];
#pragma unroll
        for (int a = 0; a < DKT; ++a)
#pragma unroll
            for (int dt = 0; dt < DT; ++dt) Sacc[a][dt] = (f32x4){0.f, 0.f, 0.f, 0.f};
        const f32x2 bg = *(const f32x2*)(bgk + e * 512 + h * 128 + dk0 + 2 * dkp);
        for (int i = tid; i < 16 * DKH; i += 512) w2s[i] = w2[(e * 16 + i / DKH) * 512 + h * 128 + dk0 + (i % DKH)];
        unsigned qraw[NP], kraw[NP]; u32x4 vraw[NV]; f32x4 g1n = (f32x4){0.f, 0.f, 0.f, 0.f};
#define GLA_LOAD_CHUNK(tk0) do { \
            const bf16_t* qp_ = PR + (size_t)((tk0) + seg * NP) * 3072 + h * 128 + dk0 + 2 * dkp; \
            _Pragma("unroll") for (int i = 0; i < NP; ++i) { qraw[i] = *(const unsigned*)(qp_ + (size_t)i * 3072); kraw[i] = *(const unsigned*)(qp_ + (size_t)i * 3072 + 512); } \
            const bf16_t* vp_ = PR + (size_t)((tk0) + lane) * 3072 + 1024 + h * 256 + dv0 + wave * DVW; \
            _Pragma("unroll") for (int jv = 0; jv < NV; ++jv) vraw[jv] = *(const u32x4*)(vp_ + 8 * jv); \
            } while (0)
#define GLA_LOAD_G1(tk0) do { if (tid < 256) g1n = *(const f32x4*)(G1 + (size_t)((tk0) + gc) * 32 + e * 16 + gr4 * 4); } while (0)
        { const int tk = t0 + (e == 0 ? 0 : nch - 1) * 64; GLA_LOAD_G1(tk); }
        if (tid < 256) *(f32x4*)(g1s + gc * 16 + gr4 * 4) = g1n;
        LDS_BARRIER();
        for (int n = 0; n < nch; ++n) {
            const int cn = e == 0 ? n : nch - 1 - n, tokc0 = t0 + cn * 64;
            const float* g1cur = g1s + (n & 1) * 1024; float* g1nxt = g1s + ((n + 1) & 1) * 1024;
            GLA_LOAD_CHUNK(tokc0);
            if (n + 1 < nch) { const int tk = t0 + (e == 0 ? n + 1 : nch - 2 - n) * 64; GLA_LOAD_G1(tk); }
            f32x2 bl[NP]; f32x2 w2r[16];
#pragma unroll
            for (int r = 0; r < 16; ++r) w2r[r] = *(const f32x2*)(w2s + r * DKH + 2 * dkp);
#pragma unroll
            for (int i = 0; i < NP; ++i) { const f32x4* gp = (const f32x4*)(g1cur + (seg * NP + i) * 16); f32x2 g = bg;
#pragma unroll
                for (int r4 = 0; r4 < 4; ++r4) { const f32x4 gv = gp[r4]; g += w2r[4 * r4] * gv[0]; g += w2r[4 * r4 + 1] * gv[1]; g += w2r[4 * r4 + 2] * gv[2]; g += w2r[4 * r4 + 3] * gv[3]; }
                const f32x2 ag = __builtin_elementwise_abs(g) * (-LOG2E); f32x2 t; t.x = __builtin_amdgcn_logf(1.0f + __builtin_amdgcn_exp2f(ag.x)); t.y = __builtin_amdgcn_logf(1.0f + __builtin_amdgcn_exp2f(ag.y));
                const f32x2 mg = __builtin_elementwise_min(g, (f32x2){0.f, 0.f});
                bl[i] = (mg * LOG2E - t) * (1.0f / 16.0f); }
            if (e == 0) {
#pragma unroll
                for (int i = 1; i < NP; ++i) bl[i] += bl[i - 1];
            } else {
#pragma unroll
                for (int i = NP - 2; i >= 0; --i) bl[i] += bl[i + 1];
            }
            *(f32x2*)(segtot + seg * DKH + 2 * dkp) = e == 0 ? bl[NP - 1] : bl[0];
            LDS_BARRIER();
            f32x2 off = (f32x2){0.f, 0.f}, tot = (f32x2){0.f, 0.f};
#pragma unroll
            for (int s = 0; s < NSEG; ++s) { const f32x2 sv = *(const f32x2*)(segtot + s * DKH + 2 * dkp); tot += sv; const bool inc = e == 0 ? (s < seg) : (s > seg); off += inc ? sv : (f32x2){0.f, 0.f}; }
            const f32x2 dec = ex2v(tot);
            if (seg == 0) *(f32x2*)(decs + 2 * dkp) = dec;
            f32x2 ke[NP];
#pragma unroll
            for (int i = 0; i < NP; ++i) { const f32x2 b = bl[i] + off; const f32x2 eb = ex2v(b), enb = ex2v(-b);
                const f32x2 qf = (f32x2){__uint_as_float(qraw[i] << 16), __uint_as_float(qraw[i] & 0xffff0000u)} * QSCALE * eb;
                const f32x2 kf = (f32x2){__uint_as_float(kraw[i] << 16), __uint_as_float(kraw[i] & 0xffff0000u)} * enb;
                *(unsigned*)(qd + (seg * NP + i) * 272 + dkp * 4) = pk2(qf.x, qf.y);
                *(unsigned*)(kd + (seg * NP + i) * 272 + dkp * 4) = pk2(kf.x, kf.y);
                ke[i] = kf * dec; }
            if constexpr (NP == 8) { u32x4 w0, w1; w0.x = pk2(ke[0].x, ke[1].x); w0.y = pk2(ke[2].x, ke[3].x); w0.z = pk2(ke[4].x, ke[5].x); w0.w = pk2(ke[6].x, ke[7].x);
              w1.x = pk2(ke[0].y, ke[1].y); w1.y = pk2(ke[2].y, ke[3].y); w1.z = pk2(ke[4].y, ke[5].y); w1.w = pk2(ke[6].y, ke[7].y);
              *(u32x4*)(keT + (2 * dkp) * 144 + seg * 16) = w0; *(u32x4*)(keT + (2 * dkp + 1) * 144 + seg * 16) = w1; }
            else { u32x2 w0, w1; w0.x = pk2(ke[0].x, ke[1].x); w0.y = pk2(ke[2].x, ke[3].x); w1.x = pk2(ke[0].y, ke[1].y); w1.y = pk2(ke[2].y, ke[3].y);
              *(u32x2*)(keT + (2 * dkp) * 144 + seg * 8) = w0; *(u32x2*)(keT + (2 * dkp + 1) * 144 + seg * 8) = w1; }
#pragma unroll
            for (int jv = 0; jv < NV; ++jv) { const unsigned wd[4] = {vraw[jv].x, vraw[jv].y, vraw[jv].z, vraw[jv].w};
#pragma unroll
                for (int k2 = 0; k2 < 4; ++k2) { *(bf16_t*)(vTw + (jv * 8 + 2 * k2) * 144 + lane * 2) = (bf16_t)(wd[k2] & 0xffffu); *(bf16_t*)(vTw + (jv * 8 + 2 * k2 + 1) * 144 + lane * 2) = (bf16_t)(wd[k2] >> 16); } }
            LDS_BARRIER();
            { const int st = wave >> 1, ct0 = (wave & 1) * 2;
              bf16x8 Af[KS], Bf[2][KS];
#pragma unroll
              for (int ks = 0; ks < KS; ++ks) { Af[ks] = *(const bf16x8*)(kd + (st * 16 + fr) * 272 + (ks * 32 + fq * 8) * 2);
                  Bf[0][ks] = *(const bf16x8*)(qd + (ct0 * 16 + fr) * 272 + (ks * 32 + fq * 8) * 2); Bf[1][ks] = *(const bf16x8*)(qd + ((ct0 + 1) * 16 + fr) * 272 + (ks * 32 + fq * 8) * 2); }
              __builtin_amdgcn_sched_barrier(0);
              f32x4 a0 = (f32x4){0.f, 0.f, 0.f, 0.f}, a1 = a0;
#pragma unroll
              for (int ks = 0; ks < KS; ++ks) { a0 = __builtin_amdgcn_mfma_f32_16x16x32_bf16(Af[ks], Bf[0][ks], a0, 0, 0, 0); a1 = __builtin_amdgcn_mfma_f32_16x16x32_bf16(Af[ks], Bf[1][ks], a1, 0, 0, 0); }
              const int sb = st * 16 + fq * 4;
#pragma unroll
              for (int tix = 0; tix < 2; ++tix) { const int c = (ct0 + tix) * 16 + fr; f32x4 a = tix == 0 ? a0 : a1;
#pragma unroll
                  for (int i = 0; i < 4; ++i) { const bool keep = e == 0 ? (sb + i <= c) : (sb + i > c); a[i] = keep ? a[i] : 0.f; }
                  u32x2 w; w.x = pk2(a[0], a[1]); w.y = pk2(a[2], a[3]);
                  *(u32x2*)(sc + c * 144 + sb * 2) = w; } }
            LDS_BARRIER();
            bf16x8 vf[DT][2];
#pragma unroll
            for (int dt = 0; dt < DT; ++dt)
#pragma unroll
                for (int ks = 0; ks < 2; ++ks) vf[dt][ks] = *(const bf16x8*)(vTw + (dt * 16 + fr) * 144 + (ks * 32 + fq * 8) * 2);
            f32x4 o[DT][4];
            { bf16x8 Bs[2][4];
#pragma unroll
              for (int ks = 0; ks < 2; ++ks)
#pragma unroll
                  for (int ct = 0; ct < 4; ++ct) Bs[ks][ct] = *(const bf16x8*)(sc + (ct * 16 + fr) * 144 + (ks * 32 + fq * 8) * 2);
              bf16x8 Sbf[KS][DT];
#pragma unroll
              for (int ks = 0; ks < KS; ++ks)
#pragma unroll
                  for (int dt = 0; dt < DT; ++dt) { const f32x4 x0 = Sacc[2 * ks][dt], x1 = Sacc[2 * ks + 1][dt];
                      const u32x4 w = (u32x4){pk2(x0[0], x0[1]), pk2(x0[2], x0[3]), pk2(x1[0], x1[1]), pk2(x1[2], x1[3])}; Sbf[ks][dt] = __builtin_bit_cast(bf16x8, w); }
              u32x4 Bq[2][4];
#define GLA_LDQ(buf, ks_) do { _Pragma("unroll") for (int ct = 0; ct < 4; ++ct) { \
                  const u32x2 lo_ = *(const u32x2*)(qd + (ct * 16 + fr) * 272 + ((ks_) * 32 + fq * 4) * 2), hi_ = *(const u32x2*)(qd + (ct * 16 + fr) * 272 + ((ks_) * 32 + 16 + fq * 4) * 2); \
                  Bq[buf][ct] = (u32x4){lo_.x, lo_.y, hi_.x, hi_.y}; } } while (0)
              GLA_LDQ(0, 0);
              __builtin_amdgcn_sched_barrier(0);
#pragma unroll
              for (int ct = 0; ct < 4; ++ct)
#pragma unroll
                  for (int dt = 0; dt < DT; ++dt) o[dt][ct] = __builtin_amdgcn_mfma_f32_16x16x32_bf16(vf[dt][0], Bs[0][ct], (f32x4){0.f, 0.f, 0.f, 0.f}, 0, 0, 0);
#pragma unroll
              for (int ct = 0; ct < 4; ++ct)
#pragma unroll
                  for (int dt = 0; dt < DT; ++dt) o[dt][ct] = __builtin_amdgcn_mfma_f32_16x16x32_bf16(vf[dt][1], Bs[1][ct], o[dt][ct], 0, 0, 0);
#pragma unroll
              for (int ks = 0; ks < KS; ++ks) {
                  if (ks < KS - 1) GLA_LDQ((ks + 1) & 1, ks + 1);
                  __builtin_amdgcn_sched_barrier(0);
#pragma unroll
                  for (int ct = 0; ct < 4; ++ct) { const bf16x8 B = __builtin_bit_cast(bf16x8, Bq[ks & 1][ct]);
#pragma unroll
                      for (int dt = 0; dt < DT; ++dt) o[dt][ct] = __builtin_amdgcn_mfma_f32_16x16x32_bf16(Sbf[ks][dt], B, o[dt][ct], 0, 0, 0); }
                  __builtin_amdgcn_sched_barrier(0);
              }
#undef GLA_LDQ
            }
#pragma unroll
            for (int ct = 0; ct < 4; ++ct)
#pragma unroll
                for (int dt = 0; dt < DT; ++dt) { u32x2 w; w.x = pk2(o[dt][ct][0], o[dt][ct][1]); w.y = pk2(o[dt][ct][2], o[dt][ct][3]);
                    *(u32x2*)(OUTB + (size_t)(tokc0 - orow_off + ct * 16 + fr) * ostride + h * 256 + dv0 + wave * DVW + dt * 16 + fq * 4) = w; }
            { bf16x8 Ak[2][2][2]; f32x4 dcv[2][2];
#define GLA_LDK(buf, g_) do { _Pragma("unroll") for (int d2 = 0; d2 < 2; ++d2) { dcv[buf][d2] = *(const f32x4*)(decs + ((g_) * 2 + d2) * 16 + fq * 4); \
                  _Pragma("unroll") for (int ks = 0; ks < 2; ++ks) Ak[buf][d2][ks] = *(const bf16x8*)(keT + (((g_) * 2 + d2) * 16 + fr) * 144 + (ks * 32 + fq * 8) * 2); } } while (0)
              GLA_LDK(0, 0);
#pragma unroll
              for (int g = 0; g < DKT / 2; ++g) {
                  if (g < DKT / 2 - 1) GLA_LDK((g + 1) & 1, g + 1);
                  __builtin_amdgcn_sched_barrier(0);
#pragma unroll
                  for (int d2 = 0; d2 < 2; ++d2) { const int dkt = g * 2 + d2;
#pragma unroll
                      for (int dt = 0; dt < DT; ++dt) Sacc[dkt][dt] *= dcv[g & 1][d2];
#pragma unroll
                      for (int ks = 0; ks < 2; ++ks)
#pragma unroll
                          for (int dt = 0; dt < DT; ++dt) Sacc[dkt][dt] = __builtin_amdgcn_mfma_f32_16x16x32_bf16(Ak[g & 1][d2][ks], vf[dt][ks], Sacc[dkt][dt], 0, 0, 0); }
                  __builtin_amdgcn_sched_barrier(0);
              }
#undef GLA_LDK
            }
            if (tid < 256 && n + 1 < nch) *(f32x4*)(g1nxt + gc * 16 + gr4 * 4) = g1n;
            LDS_BARRIER();
        }
#undef GLA_LOAD_CHUNK
#undef GLA_LOAD_G1
    }
}

__device__ __forceinline__ void phase_gla_mfma(const Params& p, int jl, unsigned char* lds) {
    const int G = gridDim.x, bx = blockIdx.x;
    int idx = bx, round = 0;
    while (idx < 384) {
        if (idx < 128) { const int chain = idx >> 2, half = (idx >> 1) & 1, dvh = idx & 1, seq = 32 + (chain >> 3), h = (chain >> 1) & 3, e = chain & 1;
            bf16_t* ob; int ostride, ooff;
            if (half == 0) { ob = (bf16_t*)(p.ws + (e == 0 ? WS_A : WS_O2)); ostride = 1024; ooff = 0; }
            else { ob = (bf16_t*)p.out + 1024; ostride = 2048; ooff = e == 0 ? 0 : NPT; }
            gla_chain<64, 16>(p, jl, lds, seq, h, e, half * 64, dvh * 128, ob, ostride, ooff);
        } else { const int c2 = idx - 128, seq = c2 >> 3, h = (c2 >> 1) & 3, e = c2 & 1;
            gla_chain<128, 32>(p, jl, lds, seq, h, e, 0, 0, (bf16_t*)(p.ws + (e == 0 ? WS_A : WS_O2)), 1024, 0);
        }
        ++round;
        if (G == 256) idx = (round == 1 && bx >= 128) ? 128 + bx : 384; else idx += G;
    }
}
#define GLA_PHASE phase_gla_mfma
#define SGU_PHASE phase_sgu_mfma

__global__ void __launch_bounds__(512, 2) fwd_kernel(Params p) {
    extern __shared__ __attribute__((aligned(16))) unsigned char lds[];
    cg::grid_group grid = cg::this_grid();
    const int G = gridDim.x;
    { volatile LAS unsigned* st0 = (volatile LAS unsigned*)((LAS unsigned char*)lds + 132096); if (threadIdx.x < 4) st0[threadIdx.x] = 0u; }
    __syncthreads();
    XcdBarrier bar = xcd_barrier_post((unsigned*)(p.ws + WS_BAR), (volatile LAS unsigned*)((LAS unsigned char*)lds + 132096));
    PG8_LAS unsigned char* glds = (PG8_LAS unsigned char*)lds;
#define RA ((bf16_t*)(p.ws + WS_A))
#define RO2 ((bf16_t*)(p.ws + WS_O2))
#define RB ((bf16_t*)(p.ws + WS_B))
#define W1 ((const bf16_t*)(p.ws + WS_W1))
#define W2 ((const bf16_t*)(p.ws + WS_W2))
#define W3 ((const bf16_t*)(p.ws + WS_W3))
#define W4 ((const bf16_t*)(p.ws + WS_W4))

    phase_mod(p, lds);
    grid.sync();
    for (int l = 0; l < 4; ++l) {
        const bool gla = (l & 1) == 0; const int jl = l >> 1;
        phase_convert(p, l, lds);
        if (l == 0) phase_elem<0>(p,   false, -1, 5, 3,   0,   true, 0, 0, 0);
        else phase_elem<1>(p, true, l - 1, 5, 3, 1, true, l, 0, 0);
        xcd_barrier(bar);
        for (int gs = 0; gs < 4; ++gs) {
            if (gs == 1) {
                if (gla) { GLA_PHASE(p, jl, lds);
                    xcd_barrier(bar); phase_gla_combine(p, jl); xcd_barrier(bar); }
                else { SGU_PHASE(p, jl, lds);
                    xcd_barrier(bar); }
            }
            if (gs == 2) { if (l == 0) phase_elem<0>(p, true, 0, 2, 1, 1, true, 0, 3, 2); else phase_elem<1>(p, true, l, 2, 1, 1, true, l, 3, 2); xcd_barrier(bar); }
            if (gs == 0 && !gla) {
                pg8::Gemm g{RA, W1, NTOK, 2048, 1024}; pg8::StaticOrder S; S.init(NTOK, 2048, G, (int)blockIdx.x);
                pg8::EpiGelu E{RB, 2048, p.in[14] + jl * 2048, (float*)(p.ws + WS_GATE), 1024};
                pg8::gemm_phase<pg8::EpiGelu, pg8::StaticOrder, true, true>(glds, g, S, E);
            } else if (gs == 2) {
                pg8::Gemm g{RA, W3, NTOK, 5632, 1024}; pg8::StaticOrder S; S.init(NTOK, 5632, G, (int)blockIdx.x);
                pg8::EpiSwiGLU E{RB, FFH};
                pg8::gemm_phase<pg8::EpiSwiGLU, pg8::StaticOrder, true, true>(glds, g, S, E);
            } else {
                pg8::Gemm g; pg8::EpiPlain E;
                if (gs == 0)      { g = pg8::Gemm{RA, W1, NTOK, 3328, 1024}; E = pg8::EpiPlain{RB, 3072, 3072, (float*)(p.ws + WS_GATE)}; }
                else if (gs == 1) { g = pg8::Gemm{RA, W2, NTOK, 1024, 1024}; E = pg8::EpiPlain{RO2, 1024, 1024, nullptr}; }
                else              { g = pg8::Gemm{RB, W4, NTOK, 1024, FFH};  E = pg8::EpiPlain{RO2, 1024, 1024, nullptr}; }
                pg8::StaticOrder S; S.init(g.M, g.N, G, (int)blockIdx.x);
                pg8::gemm_phase<pg8::EpiPlain, pg8::StaticOrder, true, true>(glds, g, S, E);
            }
            xcd_barrier(bar);
        }
    }
    phase_elem<1>(p, true, 3, 5, 3, 2, false, 0, 0, 0);
}

extern "C" void kernel_launch(void* const* d_in, const int* in_sizes, int n_in, void* d_out, int out_size, void* d_ws, size_t ws_size, hipStream_t stream) {
    static int grid = 0;
    if (grid == 0) {
        if (n_in != 22 || out_size != NTOK * D || ws_size < WS_END) { fprintf(stderr, "kernel_launch: unexpected shapes: n_in %d out %d ws %zu (need %zu)\n", n_in, out_size, ws_size, (size_t)WS_END); grid = -1; return; }
        int dev = 0, cus = 0, per_cu = 0;
        if (hipGetDevice(&dev) != hipSuccess || hipDeviceGetAttribute(&cus, hipDeviceAttributeMultiprocessorCount, dev) != hipSuccess) { grid = -1; return; }
        if (hipFuncSetAttribute((const void*)fwd_kernel, hipFuncAttributeMaxDynamicSharedMemorySize, LDS_BYTES) != hipSuccess) { fprintf(stderr, "kernel_launch: hipFuncSetAttribute failed\n"); grid = -1; return; }
        if (hipOccupancyMaxActiveBlocksPerMultiprocessor(&per_cu, (const void*)fwd_kernel, 512, LDS_BYTES) != hipSuccess || per_cu < 1) { fprintf(stderr, "kernel_launch: occupancy query says %d\n", per_cu); per_cu = 1; }
        (void)hipGetLastError();
        grid = cus * 1;
    }
    if (grid < 0) return;
    if (hipMemsetAsync((char*)d_ws + WS_BAR, 0, 16384, stream) != hipSuccess) { fprintf(stderr, "kernel_launch: memset of the barrier words failed\n"); return; }
    Params p{};
    for (int i = 0; i < 22; ++i) p.in[i] = (const float*)d_in[i];
    p.out = (float*)d_out; p.ws = (unsigned char*)d_ws;
    void* args[] = {&p};
    hipError_t e = hipLaunchCooperativeKernel((const void*)fwd_kernel, dim3(grid), dim3(512), args, LDS_BYTES, stream);
    if (e != hipSuccess) fprintf(stderr, "cooperative launch failed: %s (grid %d)\n", hipGetErrorString(e), grid);
}
```
